# Optimizing an MI355X kernel written in HIP

```python
import jax, jax.numpy as jnp
from jax import lax
import numpy as np

D_MODEL = 1024
BATCH = 16
SEQ = 4096
DEPTH = 1

N_META = 16
CHUNK = 64
N_PAD = CHUNK - N_META
DN_HEADS = 4
DN_DK = 128
DN_DV = 128
CONV_K = 4
GLA_HEADS = 4
GLA_DK = 64
GLA_DV = 128
GLA_RANK = 16
GLA_NORMALIZER = 16.0
D_FF = 4 * D_MODEL
EPS = 1e-6

DN_QK = DN_HEADS * DN_DK
DN_V = DN_HEADS * DN_DV
GLA_QK = GLA_HEADS * GLA_DK
GLA_V = GLA_HEADS * GLA_DV
MIX_WIDTH = DN_V + GLA_V
SPLITS = (DN_QK, DN_QK, DN_V, DN_V, DN_HEADS, DN_HEADS, GLA_QK, GLA_QK, GLA_V, GLA_V, GLA_RANK)
IN_WIDTH = DN_QK * 2 + DN_V * 2 + DN_HEADS * 2 + GLA_QK * 2 + GLA_V * 2 + GLA_RANK

kernel_name = "hymba_gdn_gla_hybrid"


def rmsnorm(x, g):
    xf = x.astype(jnp.float32)
    y = xf * lax.rsqrt(jnp.mean(xf * xf, axis=-1, keepdims=True) + EPS)
    return (y * g.astype(jnp.float32)).astype(x.dtype)


def l2norm(x):
    xf = x.astype(jnp.float32)
    return xf * lax.rsqrt(jnp.sum(xf * xf, axis=-1, keepdims=True) + EPS)


def causal_conv(x, w):
    K = w.shape[0]
    T = x.shape[1]
    xp = jnp.pad(x, ((0, 0), (K - 1, 0), (0, 0)))
    y = xp[:, 0:T] * w[0]
    for i in range(1, K):
        y = y + xp[:, i:i + T] * w[i]
    return y


def to_head_chunks(x, n_heads):
    B, T, W = x.shape
    return x.reshape(B, T // CHUNK, CHUNK, n_heads, W // n_heads).transpose(0, 3, 1, 2, 4)


def scalar_chunks(x):
    B, T, H = x.shape
    return x.reshape(B, T // CHUNK, CHUNK, H).transpose(0, 3, 1, 2)


def from_head_chunks(o):
    B, H, N, C, d = o.shape
    return o.transpose(0, 2, 3, 1, 4).reshape(B, N * C, H, d)


def gated_delta_chunked(q, k, v, beta, g):
    B, H, N, C, dk = q.shape
    dv = v.shape[-1]
    q = q * (dk ** -0.5)
    gc = jnp.cumsum(g, axis=-1)
    tril = jnp.tril(jnp.ones((C, C), dtype=bool))
    strict = jnp.tril(jnp.ones((C, C), dtype=bool), -1)
    decay = jnp.exp(jnp.where(tril, gc[..., :, None] - gc[..., None, :], -jnp.inf))
    kb = k * beta[..., None]
    a = jnp.einsum('bhncd,bhnsd->bhncs', kb, k) * decay
    m = jnp.eye(C, dtype=jnp.float32) + jnp.where(strict, a, 0.0)
    rhs = jnp.concatenate([v * beta[..., None], kb * jnp.exp(gc)[..., None]], axis=-1)
    sol = lax.linalg.triangular_solve(m, rhs, left_side=True, lower=True, unit_diagonal=True)
    u = sol[..., :dv]
    w = sol[..., dv:]
    attn = jnp.einsum('bhncd,bhnsd->bhncs', q, k) * decay
    qg = q * jnp.exp(gc)[..., None]
    kd = k * jnp.exp(gc[..., -1:] - gc)[..., None]
    glast = jnp.exp(gc[..., -1])

    def step(S, xs):
        u_c, w_c, attn_c, qg_c, kd_c, gl_c = xs
        v_new = u_c - jnp.einsum('bhcd,bhde->bhce', w_c, S)
        o = jnp.einsum('bhcd,bhde->bhce', qg_c, S) + jnp.einsum('bhcs,bhse->bhce', attn_c, v_new)
        S = S * gl_c[..., None, None] + jnp.einsum('bhcd,bhce->bhde', kd_c, v_new)
        return S, o

    xs = (jnp.moveaxis(u, 2, 0), jnp.moveaxis(w, 2, 0), jnp.moveaxis(attn, 2, 0),
          jnp.moveaxis(qg, 2, 0), jnp.moveaxis(kd, 2, 0), jnp.moveaxis(glast, 2, 0))
    S0 = jnp.zeros((B, H, dk, dv), jnp.float32)
    _, o = lax.scan(step, S0, xs)
    return jnp.moveaxis(o, 0, 2)


def gla_chunked(q, k, v, g):
    B, H, N, C, dk = q.shape
    dv = v.shape[-1]
    q = q * (dk ** -0.5)
    b = jnp.cumsum(g, axis=-2)
    bref = b[..., C // 2:C // 2 + 1, :]
    qi = q * jnp.exp(b - bref)
    ki = k * jnp.exp(bref - b)
    tril = jnp.tril(jnp.ones((C, C), dtype=bool))
    A = jnp.where(tril, jnp.einsum('bhncd,bhnsd->bhncs', qi, ki), 0.0)
    o_intra = jnp.einsum('bhncs,bhnse->bhnce', A, v)
    qg = q * jnp.exp(b)
    kd = k * jnp.exp(b[..., -1:, :] - b)
    glast = jnp.exp(b[..., -1, :])

    def step(S, xs):
        qg_c, kd_c, v_c, gl_c = xs
        o = jnp.einsum('bhcd,bhde->bhce', qg_c, S)
        S = S * gl_c[..., None] + jnp.einsum('bhcd,bhce->bhde', kd_c, v_c)
        return S, o

    xs = (jnp.moveaxis(qg, 2, 0), jnp.moveaxis(kd, 2, 0), jnp.moveaxis(v, 2, 0), jnp.moveaxis(glast, 2, 0))
    S0 = jnp.zeros((B, H, dk, dv), jnp.float32)
    _, o_inter = lax.scan(step, S0, xs)
    return o_intra + jnp.moveaxis(o_inter, 0, 2)


def hybrid_layer(x, valid, norm1_g, w_in, conv_w, a_log, dt_bias, dn_norm_g,
                 gla_w2, gla_b, gla_norm_g, w_out, norm2_g, w_up, w_down):
    B, T, _ = x.shape
    vmask = valid[None, :, None]
    h = jnp.where(vmask, rmsnorm(x, norm1_g), 0).astype(x.dtype)
    proj = h @ w_in
    offs = [0]
    for s in SPLITS:
        offs.append(offs[-1] + s)
    (dq, dk_, dv, dz, db, da, gq, gk, gv, gr, glr) = [proj[..., offs[i]:offs[i + 1]] for i in range(len(SPLITS))]

    qkv = jax.nn.silu(causal_conv(jnp.concatenate([dq, dk_, dv], axis=-1), conv_w))
    q_dn = l2norm(to_head_chunks(qkv[..., :DN_QK], DN_HEADS))
    k_dn = l2norm(to_head_chunks(qkv[..., DN_QK:2 * DN_QK], DN_HEADS))
    v_dn = to_head_chunks(qkv[..., 2 * DN_QK:], DN_HEADS).astype(jnp.float32)
    beta = jax.nn.sigmoid(db.astype(jnp.float32))
    g_dn = -jnp.exp(a_log.astype(jnp.float32)) * jax.nn.softplus(da.astype(jnp.float32) + dt_bias.astype(jnp.float32))
    g_dn = jnp.where(vmask, g_dn, 0.0)
    o_dn = from_head_chunks(gated_delta_chunked(q_dn, k_dn, v_dn, scalar_chunks(beta), scalar_chunks(g_dn)))
    o_dn = rmsnorm(o_dn, dn_norm_g) * jax.nn.silu(dz.reshape(B, T, DN_HEADS, DN_DV).astype(jnp.float32))
    o_dn = o_dn.reshape(B, T, DN_V)

    g_gla = jax.nn.log_sigmoid((glr @ gla_w2 + gla_b).astype(jnp.float32)) / GLA_NORMALIZER
    g_gla = jnp.where(vmask, g_gla, 0.0)
    o_gla = gla_chunked(to_head_chunks(gq, GLA_HEADS).astype(jnp.float32),
                        to_head_chunks(gk, GLA_HEADS).astype(jnp.float32),
                        to_head_chunks(gv, GLA_HEADS).astype(jnp.float32),
                        to_head_chunks(g_gla, GLA_HEADS))
    o_gla = rmsnorm(from_head_chunks(o_gla), gla_norm_g) * jax.nn.silu(gr.reshape(B, T, GLA_HEADS, GLA_DV).astype(jnp.float32))
    o_gla = o_gla.reshape(B, T, GLA_V)

    mix = jnp.concatenate([o_dn, o_gla], axis=-1).astype(x.dtype)
    x = x + mix @ w_out

    h2 = rmsnorm(x, norm2_g)
    x = x + jnp.square(jax.nn.relu(h2 @ w_up)) @ w_down
    return x


def setup_inputs(seed: int = 0) -> dict:
    key = jax.random.key(seed)
    ks = jax.random.split(key, 20)
    f32 = jnp.float32
    x = jax.random.normal(ks[0], (BATCH, SEQ, D_MODEL), f32)
    meta_tokens = jax.random.normal(ks[1], (N_META, D_MODEL), f32)
    norm1_g = 1.0 + 0.02 * jax.random.normal(ks[2], (DEPTH, D_MODEL), f32)
    w_in = jax.random.normal(ks[3], (DEPTH, D_MODEL, IN_WIDTH), f32) * D_MODEL ** -0.5
    conv_w = jax.random.normal(ks[4], (DEPTH, CONV_K, 2 * DN_QK + DN_V), f32) * CONV_K ** -0.5
    a_log = jnp.log(jax.random.uniform(ks[5], (DEPTH, DN_HEADS), f32, 1.0, 16.0))
    dt = jnp.exp(jax.random.uniform(ks[6], (DEPTH, DN_HEADS), f32, math_log(0.001), math_log(0.1)))
    dt_bias = dt + jnp.log(-jnp.expm1(-dt))
    dn_norm_g = 1.0 + 0.02 * jax.random.normal(ks[7], (DEPTH, DN_DV), f32)
    gla_w2 = jax.random.normal(ks[8], (DEPTH, GLA_RANK, GLA_QK), f32) * GLA_RANK ** -0.5
    gla_b = 0.01 * jax.random.normal(ks[9], (DEPTH, GLA_QK), f32)
    gla_norm_g = 1.0 + 0.02 * jax.random.normal(ks[10], (DEPTH, GLA_DV), f32)
    w_out = jax.random.normal(ks[11], (DEPTH, MIX_WIDTH, D_MODEL), f32) * MIX_WIDTH ** -0.5
    norm2_g = 1.0 + 0.02 * jax.random.normal(ks[12], (DEPTH, D_MODEL), f32)
    w_up = jax.random.normal(ks[13], (DEPTH, D_MODEL, D_FF), f32) * D_MODEL ** -0.5
    w_down = jax.random.normal(ks[14], (DEPTH, D_FF, D_MODEL), f32) * D_FF ** -0.5
    final_norm_g = 1.0 + 0.02 * jax.random.normal(ks[15], (D_MODEL,), f32)
    return {"x": x, "meta_tokens": meta_tokens, "norm1_g": norm1_g, "w_in": w_in, "conv_w": conv_w,
            "a_log": a_log, "dt_bias": dt_bias, "dn_norm_g": dn_norm_g, "gla_w2": gla_w2, "gla_b": gla_b,
            "gla_norm_g": gla_norm_g, "w_out": w_out, "norm2_g": norm2_g, "w_up": w_up, "w_down": w_down,
            "final_norm_g": final_norm_g}


def math_log(v):
    return float(np.log(v))


def reference(x, meta_tokens, norm1_g, w_in, conv_w, a_log, dt_bias, dn_norm_g, gla_w2, gla_b,
              gla_norm_g, w_out, norm2_g, w_up, w_down, final_norm_g):
    B = x.shape[0]
    pad = jnp.zeros((B, N_PAD, D_MODEL), x.dtype)
    meta = jnp.broadcast_to(meta_tokens.astype(x.dtype)[None], (B, N_META, D_MODEL))
    h = jnp.concatenate([pad, meta, x], axis=1)
    T = h.shape[1]
    valid = jnp.arange(T) >= N_PAD
    for l in range(DEPTH):
        h = hybrid_layer(h, valid, norm1_g[l], w_in[l], conv_w[l], a_log[l], dt_bias[l], dn_norm_g[l],
                         gla_w2[l], gla_b[l], gla_norm_g[l], w_out[l], norm2_g[l], w_up[l], w_down[l])
    return rmsnorm(h, final_norm_g)[:, CHUNK:]
```

```cpp
#include <hip/hip_runtime.h>
#include <hip/hip_cooperative_groups.h>
#include <cstdio>
#include <cstdint>
namespace cg = cooperative_groups;
namespace pg8 {
#define PG8_LAS __attribute__((address_space(3)))
typedef unsigned short bf16_t;
typedef short bf16x8 __attribute__((ext_vector_type(8)));
typedef float f32x4 __attribute__((ext_vector_type(4)));
typedef unsigned u32x4 __attribute__((ext_vector_type(4)));
constexpr int BM = 256, BK = 64, HALF = 128, HTB = HALF * BK * 2  , STAGE_BYTES = 8 * HTB, NXCD = 8, WGM = 8;

__host__ __device__ __forceinline__ int lds_byte(int r, int c) { const int st = (r >> 4) * 2 + (c >> 5), rr = r & 15, cc = c & 31, ob = rr * 64 + cc * 2; return st * 1024 + (ob ^ (((ob >> 9) & 1) << 5)); }
__host__ __device__ __forceinline__ void stage_rc(int b, int& R, int& C) { const int st = b / 1024, sb = b % 1024, swz = sb ^ (((sb >> 9) & 1) << 5); R = (st >> 1) * 16 + swz / 64; C = (st & 1) * 32 + (swz % 64) / 2; }
__host__ __device__ __forceinline__ int perm32(int rho) { const int n = rho >> 4, i = rho & 15; return 8 * (i >> 2) + 4 * n + (i & 3); }

struct Unit { int pm, pn; };
struct Gemm { const bf16_t* A; const bf16_t* Bt; int M, N, K; };

struct StaticOrder {
    int nM, nN, nwg, G, c;
    __host__ __device__ void init(int M, int N, int G_, int c_) { nM = M / BM; nN = N / BM; nwg = nM * nN; G = G_; c = c_; }
    __host__ __device__ bool next(int i, Unit& u) const {
        const long L = (long)i * G + c; if (L >= nwg) return false;
        int wgid = (int)L; { const int q = nwg / NXCD, r = nwg % NXCD, xcd = wgid % NXCD, off = wgid / NXCD; wgid = (xcd < r ? xcd * (q + 1) : r * (q + 1) + (xcd - r) * q) + off; }
        const int nig = WGM * nN, gid = wgid / nig, fm = gid * WGM, gsz = (nM - fm) < WGM ? (nM - fm) : WGM;
        u.pm = fm + ((wgid % nig) % gsz); u.pn = (wgid % nig) / gsz; return true;
    }
    __device__ __forceinline__ void a_ready(const Unit&) const {}
    __device__ __forceinline__ void done(const Unit&) const {}
};

__device__ __forceinline__ unsigned cvt_pk_bf16(float lo, float hi) { unsigned r; asm volatile("v_cvt_pk_bf16_f32 %0, %1, %2" : "=v"(r) : "v"(lo), "v"(hi)); return r; }
typedef float f32x2 __attribute__((ext_vector_type(2)));
__device__ __forceinline__ f32x2 gelu_pk(f32x2 v) {
    const f32x2 av = __builtin_elementwise_abs(v), d = av * 0.2316418882f + 1.0f;
    f32x2 t; t.x = __builtin_amdgcn_rcpf(d.x); t.y = __builtin_amdgcn_rcpf(d.y);
    f32x2 q = t * 0.5307027145f + (-0.7265760135f); q = q * t + 0.7107068705f; q = q * t + (-0.142248368f); q = q * t + 0.127414796f; q = q * t;
    const f32x2 s = (v * v) * (-0.72134752044f);
    f32x2 e; e.x = __builtin_amdgcn_exp2f(s.x); e.y = __builtin_amdgcn_exp2f(s.y);
    const f32x2 m = v * (q * e), r = v - m;
    f32x2 o; o.x = v.x < 0.f ? m.x : r.x; o.y = v.y < 0.f ? m.y : r.y; return o;
}

template <int ACT  > struct EpiBf16 {
    static constexpr bool PERM = true, AFTER_DRAIN = false; static_assert(ACT == 0 || ACT == 1, "EpiBf16: ACT is 0 (none) or 1 (gelu_pk)");
    bf16_t* O; int ldc; const float* bias; int split_cols; size_t split_stride; float scale0;
    __device__ __forceinline__ void operator()(const f32x4 (&acc)[2][2][4][2], const Unit& u, int wr, int wc, int fr, int fq) const {
        const int row0 = u.pm * BM + wr * 64 + fr; int colt = u.pn * BM; bf16_t* base = O;
        float sc = 1.f; if (split_cols) { const int t = colt / split_cols; base += (size_t)t * split_stride; colt -= t * split_cols; if (t == 0) sc = scale0; }
        const int col0 = colt + wc * 32 + 8 * fq, bcol0 = u.pn * BM + wc * 32 + 8 * fq;
        f32x4 bv[2][2];
#pragma unroll
        for (int bj = 0; bj < 2; ++bj)
#pragma unroll
            for (int n = 0; n < 2; ++n) bv[bj][n] = bias ? *(const f32x4*)(bias + bcol0 + bj * HALF + 4 * n) : (f32x4){0.f, 0.f, 0.f, 0.f};
#pragma unroll
        for (int ai = 0; ai < 2; ++ai)
#pragma unroll
            for (int m = 0; m < 4; ++m) { bf16_t* rowp = base + (size_t)(row0 + ai * HALF + m * 16) * ldc + col0;
#pragma unroll
                for (int bj = 0; bj < 2; ++bj) { f32x4 v0 = acc[ai][bj][m][0] + bv[bj][0], v1 = acc[ai][bj][m][1] + bv[bj][1];
                    if (ACT == 1) { f32x2 a = gelu_pk((f32x2){v0[0], v0[1]}), b = gelu_pk((f32x2){v0[2], v0[3]}), c = gelu_pk((f32x2){v1[0], v1[1]}), d = gelu_pk((f32x2){v1[2], v1[3]});
                        v0 = (f32x4){a.x, a.y, b.x, b.y}; v1 = (f32x4){c.x, c.y, d.x, d.y}; }
                    v0 = v0 * sc; v1 = v1 * sc; u32x4 w; w.x = cvt_pk_bf16(v0[0], v0[1]); w.y = cvt_pk_bf16(v0[2], v0[3]); w.z = cvt_pk_bf16(v1[0], v1[1]); w.w = cvt_pk_bf16(v1[2], v1[3]);
                    *(u32x4*)(rowp + bj * HALF) = w; } }
    }
};

struct EpiRelu2Bf16 {
    static constexpr bool PERM = true, AFTER_DRAIN = false;
    bf16_t* O; int ldc;
    __device__ __forceinline__ void operator()(const f32x4 (&acc)[2][2][4][2], const Unit& u, int wr, int wc, int fr, int fq) const {
        const int row0 = u.pm * BM + wr * 64 + fr; const int col0 = u.pn * BM + wc * 32 + 8 * fq;
#pragma unroll
        for (int ai = 0; ai < 2; ++ai)
#pragma unroll
            for (int m = 0; m < 4; ++m) { bf16_t* rowp = O + (size_t)(row0 + ai * HALF + m * 16) * ldc + col0;
#pragma unroll
                for (int bj = 0; bj < 2; ++bj) { f32x4 v0 = acc[ai][bj][m][0], v1 = acc[ai][bj][m][1];
#pragma unroll
                    for (int i = 0; i < 4; ++i) { float a0 = v0[i] > 0.f ? v0[i] : 0.f, a1 = v1[i] > 0.f ? v1[i] : 0.f; v0[i] = a0 * a0; v1[i] = a1 * a1; }
                    u32x4 w; w.x = cvt_pk_bf16(v0[0], v0[1]); w.y = cvt_pk_bf16(v0[2], v0[3]); w.z = cvt_pk_bf16(v1[0], v1[1]); w.w = cvt_pk_bf16(v1[2], v1[3]);
                    *(u32x4*)(rowp + bj * HALF) = w; } }
    }
};
struct EpiResF32 {
    static constexpr bool PERM = false, AFTER_DRAIN = false;
    const float* base; float* out; int ldc;
    __device__ __forceinline__ void operator()(const f32x4 (&acc)[2][2][4][2], const Unit& u, int wr, int wc, int fr, int fq) const {
        const int col0 = u.pn * BM + wc * 32 + 4 * fq;
#pragma unroll
        for (int ai = 0; ai < 2; ++ai)
#pragma unroll
            for (int m = 0; m < 4; ++m) { const size_t off = (size_t)(u.pm * BM + ai * HALF + wr * 64 + m * 16 + fr) * ldc + col0;
#pragma unroll
                for (int bj = 0; bj < 2; ++bj)
#pragma unroll
                    for (int n = 0; n < 2; ++n) { const f32x4 bs = *(const f32x4*)(base + off + bj * HALF + n * 16); *(f32x4*)(out + off + bj * HALF + n * 16) = bs + acc[ai][bj][m][n]; } }
    }
};
template <class Epi, class Sched, bool ALIGN_EPI = false, bool SP2 = false>
__device__ __forceinline__ void gemm_phase(PG8_LAS unsigned char* lds, const Gemm g, const Sched& S, const Epi& E) {
    const int tid = threadIdx.x, wid = __builtin_amdgcn_readfirstlane(tid >> 6), lane = tid & 63, wr = wid >> 2, wc = wid & 3, fr = lane & 15, fq = lane >> 4;
    const int K = g.K, nt = K / BK;
    unsigned voffA[2], voffB[2];
#pragma unroll
    for (int i = 0; i < 2; ++i) { int R, C; stage_rc(tid * 16 + i * 8192, R, C); const int Rb = Epi::PERM ? ((R & ~31) + perm32(R & 31)) : R;
        voffA[i] = (unsigned)(R * K + C) * 2u; voffB[i] = (unsigned)(Rb * K + C) * 2u; }
    const size_t kstep = (size_t)(BK * 2);
    const size_t hstep = (size_t)HALF * K * 2;
    const size_t tstep = 2 * hstep;
    const unsigned ldsw = (unsigned)wid * 1024u;
    const int aoff = lds_byte(wr * 64 + fr, fq * 8), boff = lds_byte(wc * 32 + fr, fq * 8);
#define PG8_SA(b, h) (((b) * 2 + (h)) * HTB)
#define PG8_SB(b, h) ((4 + (b) * 2 + (h)) * HTB)
#define PG8_STAGE(bufoff, gbase, voff) do { _Pragma("unroll") for (int _i = 0; _i < 2; ++_i) \
        __builtin_amdgcn_global_load_lds((const unsigned*)((const char*)(gbase) + (voff)[_i]), (PG8_LAS unsigned*)(lds + (bufoff) + ldsw + _i * 8192), 16, 0, 0); } while (0)
#define PG8_LDA(dst, b, h) do { _Pragma("unroll") for (int m = 0; m < 4; ++m) _Pragma("unroll") for (int k = 0; k < 2; ++k) dst[m][k] = *(const PG8_LAS bf16x8*)(lds + PG8_SA(b, h) + aoff + m * 2048 + k * 1024); } while (0)
#define PG8_LDB(dst, b, h) do { _Pragma("unroll") for (int n = 0; n < 2; ++n) _Pragma("unroll") for (int k = 0; k < 2; ++k) dst[n][k] = *(const PG8_LAS bf16x8*)(lds + PG8_SB(b, h) + boff + n * 2048 + k * 1024); } while (0)
#define PG8_MMA(ai, bj, At, Bt) do { __builtin_amdgcn_s_setprio(1); _Pragma("unroll") for (int m = 0; m < 4; ++m) _Pragma("unroll") for (int n = 0; n < 2; ++n) _Pragma("unroll") for (int k = 0; k < 2; ++k) \
        acc[ai][bj][m][n] = __builtin_amdgcn_mfma_f32_16x16x32_bf16(Bt[n][k], At[m][k], acc[ai][bj][m][n], 0, 0, 0); __builtin_amdgcn_s_setprio(0); } while (0)
#define PG8_WAIT_V(n) asm volatile("s_waitcnt vmcnt(" #n ")" ::: "memory")
#define PG8_WAIT_L(n) asm volatile("s_waitcnt lgkmcnt(" #n ")" ::: "memory")
#define PG8_BAR __builtin_amdgcn_s_barrier()
#define PG8_SCHED __builtin_amdgcn_sched_barrier(0)
    Unit cur, nxt; int ui = 0;
    if (!S.next(0, cur)) return;
    f32x4 acc[2][2][4][2];
#pragma unroll
    for (int a = 0; a < 2; ++a)
#pragma unroll
        for (int b = 0; b < 2; ++b)
#pragma unroll
            for (int m = 0; m < 4; ++m)
#pragma unroll
                for (int n = 0; n < 2; ++n) acc[a][b][m][n] = (f32x4){0.f, 0.f, 0.f, 0.f};
    bf16x8 At[4][2], B0[2][2], B1[2][2];
    const char* cA = (const char*)g.A + (size_t)cur.pm * tstep; const char* cB = (const char*)g.Bt + (size_t)cur.pn * tstep;
    S.a_ready(cur);
    if constexpr (SP2) {
        PG8_STAGE(PG8_SB(0, 0), cB, voffB); PG8_STAGE(PG8_SB(0, 1), cB + hstep, voffB); PG8_STAGE(PG8_SA(0, 0), cA, voffA); PG8_STAGE(PG8_SA(0, 1), cA + hstep, voffA);
        if (wr == 1) PG8_BAR;
        PG8_WAIT_V(2); PG8_BAR;
        PG8_STAGE(PG8_SB(1, 0), cB + kstep, voffB); PG8_STAGE(PG8_SA(1, 0), cA + kstep, voffA); PG8_STAGE(PG8_SB(1, 1), cB + hstep + kstep, voffB);
        PG8_WAIT_V(6); PG8_BAR;
    } else {
        PG8_STAGE(PG8_SB(0, 0), cB, voffB); PG8_STAGE(PG8_SA(0, 0), cA, voffA); PG8_STAGE(PG8_SB(0, 1), cB + hstep, voffB); PG8_STAGE(PG8_SA(0, 1), cA + hstep, voffA);
        if (wr == 1) PG8_BAR;
        PG8_WAIT_V(4); PG8_BAR;
        PG8_STAGE(PG8_SB(1, 0), cB + kstep, voffB); PG8_STAGE(PG8_SA(1, 0), cA + kstep, voffA); PG8_STAGE(PG8_SB(1, 1), cB + hstep + kstep, voffB);
        PG8_WAIT_V(6); PG8_BAR;
    }
    for (;;) {
        const bool has_next = S.next(ui + 1, nxt);
        const char* nA = has_next ? (const char*)g.A + (size_t)nxt.pm * tstep : cA; const char* nB = has_next ? (const char*)g.Bt + (size_t)nxt.pn * tstep : cB;
        for (int t = 0; t < nt; t += 2) {
            const bool last = (t == nt - 2);
            const char* a1 = cA + (size_t)(t + 1) * kstep;
            const char* a2 = last ? nA : cA + (size_t)(t + 2) * kstep; const char* b2 = last ? nB : cB + (size_t)(t + 2) * kstep;
            const char* a3 = a2 + kstep; const char* b3 = b2 + kstep;
            if (last && has_next) S.a_ready(nxt);
            if constexpr (SP2) {
            PG8_LDB(B0, 0, 0); PG8_LDB(B1, 0, 1); PG8_SCHED; PG8_LDA(At, 0, 0); PG8_STAGE(PG8_SA(1, 1), a1 + hstep, voffA);
            PG8_WAIT_V(8); PG8_WAIT_L(0); PG8_BAR; PG8_MMA(0, 0, At, B0); PG8_MMA(0, 1, At, B1); PG8_BAR; PG8_SCHED;
            PG8_LDA(At, 0, 1); PG8_STAGE(PG8_SB(0, 0), b2, voffB); PG8_STAGE(PG8_SB(0, 1), b2 + hstep, voffB); PG8_STAGE(PG8_SA(0, 0), a2, voffA);
            PG8_WAIT_V(8); PG8_WAIT_L(0); PG8_BAR; PG8_MMA(1, 0, At, B0); PG8_MMA(1, 1, At, B1); PG8_BAR; PG8_SCHED;
            PG8_LDB(B0, 1, 0); PG8_LDB(B1, 1, 1); PG8_SCHED; PG8_LDA(At, 1, 0); PG8_STAGE(PG8_SA(0, 1), a2 + hstep, voffA);
            PG8_WAIT_V(8); PG8_WAIT_L(0); PG8_BAR; PG8_MMA(0, 0, At, B0); PG8_MMA(0, 1, At, B1); PG8_BAR; PG8_SCHED;
            PG8_LDA(At, 1, 1); PG8_STAGE(PG8_SB(1, 0), b3, voffB); PG8_STAGE(PG8_SB(1, 1), b3 + hstep, voffB); PG8_STAGE(PG8_SA(1, 0), a3, voffA);
            PG8_WAIT_V(8); PG8_WAIT_L(0); PG8_BAR; PG8_MMA(1, 0, At, B0); PG8_MMA(1, 1, At, B1); PG8_BAR; PG8_SCHED;
            } else {
            PG8_LDB(B0, 0, 0); PG8_SCHED; PG8_LDA(At, 0, 0); PG8_STAGE(PG8_SA(1, 1), a1 + hstep, voffA);
            PG8_WAIT_L(8); PG8_BAR; PG8_WAIT_L(0); PG8_MMA(0, 0, At, B0); PG8_BAR; PG8_SCHED;
            PG8_LDB(B1, 0, 1); PG8_STAGE(PG8_SB(0, 0), b2, voffB);
            PG8_BAR; PG8_WAIT_L(0); PG8_MMA(0, 1, At, B1); PG8_BAR;
            PG8_LDA(At, 0, 1); PG8_STAGE(PG8_SA(0, 0), a2, voffA);
            PG8_BAR; PG8_WAIT_L(0); PG8_MMA(1, 0, At, B0); PG8_BAR; PG8_SCHED;
            PG8_STAGE(PG8_SB(0, 1), b2 + hstep, voffB);
            PG8_WAIT_V(6); PG8_BAR; PG8_MMA(1, 1, At, B1); PG8_BAR;
            PG8_LDB(B0, 1, 0); PG8_SCHED; PG8_LDA(At, 1, 0); PG8_STAGE(PG8_SA(0, 1), a2 + hstep, voffA);
            PG8_WAIT_L(8); PG8_BAR; PG8_WAIT_L(0); PG8_MMA(0, 0, At, B0); PG8_BAR; PG8_SCHED;
            PG8_LDB(B1, 1, 1); PG8_STAGE(PG8_SB(1, 0), b3, voffB);
            PG8_BAR; PG8_WAIT_L(0); PG8_MMA(0, 1, At, B1); PG8_BAR;
            PG8_LDA(At, 1, 1); PG8_STAGE(PG8_SA(1, 0), a3, voffA);
            PG8_BAR; PG8_WAIT_L(0); PG8_MMA(1, 0, At, B0); PG8_BAR; PG8_SCHED;
            PG8_STAGE(PG8_SB(1, 1), b3 + hstep, voffB);
            PG8_WAIT_V(6); PG8_BAR; PG8_MMA(1, 1, At, B1); PG8_BAR;
            }
        }
        if constexpr (ALIGN_EPI) { if (wr == 0) PG8_BAR; }
        if constexpr (!Epi::AFTER_DRAIN) { E(acc, cur, wr, wc, fr, fq); S.done(cur); }
        if (!has_next) break;
#pragma unroll
        for (int a = 0; a < 2; ++a)
#pragma unroll
            for (int b = 0; b < 2; ++b)
#pragma unroll
                for (int m = 0; m < 4; ++m)
#pragma unroll
                    for (int n = 0; n < 2; ++n) acc[a][b][m][n] = (f32x4){0.f, 0.f, 0.f, 0.f};
        cur = nxt; cA = nA; cB = nB; ++ui;
        if constexpr (ALIGN_EPI) { if (wr == 1) PG8_BAR; }
    }
    PG8_WAIT_V(0);
    if constexpr (!ALIGN_EPI) { if (wr == 0) PG8_BAR; }
    PG8_BAR;
    if constexpr (Epi::AFTER_DRAIN) { E.fused(acc, cur, wr, wc, fr, fq, lds, wid, lane); S.done(cur); }
#undef PG8_SA
#undef PG8_SB
#undef PG8_STAGE
#undef PG8_LDA
#undef PG8_LDB
#undef PG8_MMA
#undef PG8_WAIT_V
#undef PG8_WAIT_L
#undef PG8_BAR
#undef PG8_SCHED
}
}
#define LAS __attribute__((address_space(3)))
typedef unsigned short bf16;
typedef float f32x4 __attribute__((ext_vector_type(4)));
typedef unsigned v4u __attribute__((ext_vector_type(4)));
typedef unsigned v2u __attribute__((ext_vector_type(2)));
#define LDS_WAIT() asm volatile("s_waitcnt lgkmcnt(0)" ::: "memory")

constexpr int NWAVES = 8, NTHREADS = 512;
constexpr int BATCH = 16, SEQ = 4096, D = 1024, FF = 4096, CH = 64, TTOT = SEQ + CH, NPAD = 48;
constexpr int MR = BATCH * SEQ;
constexpr int PROWS = MR + CH;
constexpr int NIN = 3840, NIN_SRC = 3608;
constexpr int C_DQ = 0, C_DK = 512, C_DV = 1024, C_DZ = 1536, C_GQ = 2048, C_GK = 2304, C_GV = 2560, C_GR = 3072, C_BETA = 3584, C_A = 3588, C_LR = 3592;
constexpr float EPS = 1e-6f;
constexpr size_t MiB = 1u << 20;
constexpr size_t WS_WIN = 0, WS_WOUT = 8 * MiB, WS_WUP = 10 * MiB, WS_WDN = 18 * MiB, WS_HN = 32 * MiB, WS_MIX = 160 * MiB, WS_P = 288 * MiB;
constexpr int LDS_BYTES = 147456;

struct Args {
    const float *x, *meta, *norm1_g, *w_in, *conv_w, *a_log, *dt_bias, *dn_norm_g, *gla_w2, *gla_b, *gla_norm_g, *w_out, *norm2_g, *w_up, *w_down, *final_g;
    float* out; unsigned char* ws;
};

__device__ __forceinline__ unsigned f2bf(float f) { unsigned u = __builtin_bit_cast(unsigned, f); return (u + 0x7fffu + ((u >> 16) & 1u)) >> 16; }
__device__ __forceinline__ unsigned pk2(float lo, float hi) { return f2bf(lo) | (f2bf(hi) << 16); }
__device__ __forceinline__ float bf2f(unsigned short h) { return __builtin_bit_cast(float, (unsigned)h << 16); }
__device__ __forceinline__ float bflo(unsigned w) { return __builtin_bit_cast(float, w << 16); }
__device__ __forceinline__ float bfhi(unsigned w) { return __builtin_bit_cast(float, w & 0xffff0000u); }
__device__ __forceinline__ float wave_sum(float v) {
#pragma unroll
    for (int o = 1; o < 64; o <<= 1) v += __shfl_xor(v, o);
    return v;
}
__device__ __forceinline__ float sigmoidf_(float x) { return 1.f / (1.f + __expf(-x)); }
__device__ __forceinline__ float siluf_(float x) { return x / (1.f + __expf(-x)); }
__device__ __forceinline__ float softplusf_(float x) { return fmaxf(x, 0.f) + log1pf(__expf(-fabsf(x))); }
__device__ __forceinline__ float logsigmoidf_(float x) { return fminf(x, 0.f) - log1pf(__expf(-fabsf(x))); }
__device__ __forceinline__ size_t rowof(int b, int t) { return t < CH ? (size_t)(MR + t) : (size_t)(b * SEQ + t - CH); }

__device__ __forceinline__ int win_src(int n) { return n < 2048 ? n : (n < 3584 ? n + 8 : (n < 3592 ? n - 1536 : (n < 3608 ? n : -1))); }

template <bool MAP> __device__ __forceinline__ void transpose_item(const float* W, int K, int Nsrc, bf16* WT, LAS float* scr, int kb, int nb, int lane) {
    const int k0 = 64 * kb, n0 = 32 * nb;
    const int nn = n0 + (lane & 31); const int src = MAP ? win_src(nn) : nn;
#pragma unroll 8
    for (int i = 0; i < 32; ++i) { const int kk = 2 * i + (lane >> 5); scr[kk * 33 + (lane & 31)] = src >= 0 ? W[(size_t)(k0 + kk) * Nsrc + src] : 0.f; }
    LDS_WAIT();
    const int c = lane & 7;
#pragma unroll
    for (int j = 0; j < 4; ++j) { const int n = (lane >> 3) + 8 * j; const LAS float* s = scr + (8 * c) * 33 + n;
        v4u o; o.x = pk2(s[0 * 33], s[1 * 33]); o.y = pk2(s[2 * 33], s[3 * 33]); o.z = pk2(s[4 * 33], s[5 * 33]); o.w = pk2(s[6 * 33], s[7 * 33]);
        *(v4u*)(WT + (size_t)(n0 + n) * K + k0 + 8 * c) = o; }
    LDS_WAIT();
}
__device__ __forceinline__ void rms_row_to_bf16(const float* xrow, const float* g, bf16* orow, int lane) {
    const f32x4* xr = (const f32x4*)xrow + lane; f32x4 v[4]; float s = 0.f;
#pragma unroll
    for (int j = 0; j < 4; ++j) { v[j] = xr[64 * j]; s += (v[j].x * v[j].x + v[j].y * v[j].y) + (v[j].z * v[j].z + v[j].w * v[j].w); }
    const float rstd = rsqrtf(wave_sum(s) * (1.f / D) + EPS);
    unsigned long long* o8 = (unsigned long long*)orow + lane;
#pragma unroll
    for (int j = 0; j < 4; ++j) { const f32x4 gv = ((const f32x4*)g)[lane + 64 * j];
        o8[64 * j] = (unsigned long long)pk2(v[j].x * rstd * gv.x, v[j].y * rstd * gv.y) | ((unsigned long long)pk2(v[j].z * rstd * gv.z, v[j].w * rstd * gv.w) << 32); }
}
__device__ __forceinline__ void rms_row_f32(float* xrow, const float* g, int lane) {
    f32x4* xr = (f32x4*)xrow + lane; f32x4 v[4]; float s = 0.f;
#pragma unroll
    for (int j = 0; j < 4; ++j) { v[j] = xr[64 * j]; s += (v[j].x * v[j].x + v[j].y * v[j].y) + (v[j].z * v[j].z + v[j].w * v[j].w); }
    const float rstd = rsqrtf(wave_sum(s) * (1.f / D) + EPS);
#pragma unroll
    for (int j = 0; j < 4; ++j) { const f32x4 gv = ((const f32x4*)g)[lane + 64 * j]; xr[64 * j] = v[j] * rstd * gv; }
}

__device__ __forceinline__ void p0_prologue(const Args& a, LAS unsigned char* lds, int tid, int lane, int wave) {
    unsigned char* ws = a.ws;
    bf16* Win_t = (bf16*)(ws + WS_WIN); bf16* Wout_t = (bf16*)(ws + WS_WOUT); bf16* Wup_t = (bf16*)(ws + WS_WUP); bf16* Wdn_t = (bf16*)(ws + WS_WDN);
    bf16* HN = (bf16*)(ws + WS_HN); bf16* P = (bf16*)(ws + WS_P);
    const int G = gridDim.x, gw = blockIdx.x * NWAVES + wave, NGW = G * NWAVES;
    LAS float* scr = (LAS float*)(lds + wave * 16384);
    constexpr int I_IN = 16 * (NIN / 32), I_OUT = 16 * (D / 32), I_UP = 16 * (FF / 32), I_DN = (FF / 64) * (D / 32);
    constexpr int NITEMS = I_IN + I_OUT + I_UP + I_DN;
    for (int it = gw; it < NITEMS; it += NGW) {
        int r = it;
        if (r < I_IN) { transpose_item<true>(a.w_in, D, NIN_SRC, Win_t, scr, r / (NIN / 32), r % (NIN / 32), lane); continue; } r -= I_IN;
        if (r < I_OUT) { transpose_item<false>(a.w_out, D, D, Wout_t, scr, r / (D / 32), r % (D / 32), lane); continue; } r -= I_OUT;
        if (r < I_UP) { transpose_item<false>(a.w_up, D, FF, Wup_t, scr, r / (FF / 32), r % (FF / 32), lane); continue; } r -= I_UP;
        transpose_item<false>(a.w_down, FF, D, Wdn_t, scr, r / (D / 32), r % (D / 32), lane);
    }
    for (int m = gw; m < MR; m += NGW) rms_row_to_bf16(a.x + (size_t)m * D, a.norm1_g, HN + (size_t)m * D, lane);
    { v4u z = {0u, 0u, 0u, 0u}; v4u* pz = (v4u*)(P + (size_t)MR * NIN);
      for (int i = blockIdx.x * NTHREADS + tid; i < NPAD * NIN / 8; i += G * NTHREADS) pz[i] = z; }
    __syncthreads();
    LAS float* hm = (LAS float*)lds;
#pragma unroll
    for (int rr = 0; rr < 2; ++rr) { const int r = wave * 2 + rr; const f32x4* xr = (const f32x4*)(a.meta + (size_t)r * D) + lane; f32x4 v[4]; float s = 0.f;
#pragma unroll
        for (int j = 0; j < 4; ++j) { v[j] = xr[64 * j]; s += (v[j].x * v[j].x + v[j].y * v[j].y) + (v[j].z * v[j].z + v[j].w * v[j].w); }
        const float rstd = rsqrtf(wave_sum(s) * (1.f / D) + EPS);
#pragma unroll
        for (int j = 0; j < 4; ++j) { const f32x4 gv = ((const f32x4*)a.norm1_g)[lane + 64 * j]; ((LAS f32x4*)(hm + r * D))[lane + 64 * j] = v[j] * rstd * gv; } }
    __syncthreads();
    for (int cb = blockIdx.x; cb * 15 < NIN; cb += G) {
        const int j = tid >> 5, ks = tid & 31; const int n = cb * 15 + j; const int src = (j < 15 && n < NIN) ? win_src(n) : -1;
        float acc[16];
#pragma unroll
        for (int r = 0; r < 16; ++r) acc[r] = 0.f;
        if (src >= 0) {
            for (int kk = 0; kk < 32; ++kk) { const int k = kk * 32 + ks; const float w = a.w_in[(size_t)k * NIN_SRC + src];
#pragma unroll
                for (int r = 0; r < 16; ++r) acc[r] += hm[r * D + k] * w; }
        }
#pragma unroll
        for (int r = 0; r < 16; ++r) { float v = acc[r]; v += __shfl_xor(v, 1); v += __shfl_xor(v, 2); v += __shfl_xor(v, 4); v += __shfl_xor(v, 8); v += __shfl_xor(v, 16); acc[r] = v; }
        float val = 0.f;
#pragma unroll
        for (int r = 0; r < 16; ++r) if (ks == r) val = acc[r];
        if (j < 15 && n < NIN && ks < 16) P[(size_t)(MR + NPAD + ks) * NIN + n] = (bf16)f2bf(val);
    }
    __syncthreads();
}

__device__ __forceinline__ void dn_scan_naive(const Args& a, int unit, LAS float* sw, int lane) {
    const int b = unit >> 4, h = (unit >> 2) & 3, qt = unit & 3, el = lane & 31, dh = lane >> 5, e = qt * 32 + el;
    const bf16* P = (const bf16*)(a.ws + WS_P); bf16* O = (bf16*)(a.ws + WS_MIX);
    const int cq0 = C_DQ + h * 128 + lane, cq1 = cq0 + 64, ck0 = C_DK + h * 128 + lane, ck1 = ck0 + 64, cv = C_DV + h * 128 + e;
    float wq0[4], wq1[4], wk0[4], wk1[4], wv[4];
#pragma unroll
    for (int i = 0; i < 4; ++i) { wq0[i] = a.conv_w[i * 1536 + cq0]; wq1[i] = a.conv_w[i * 1536 + cq1]; wk0[i] = a.conv_w[i * 1536 + ck0]; wk1[i] = a.conv_w[i * 1536 + ck1]; wv[i] = a.conv_w[i * 1536 + cv]; }
    float hq0[3] = {0.f, 0.f, 0.f}, hq1[3] = {0.f, 0.f, 0.f}, hk0[3] = {0.f, 0.f, 0.f}, hk1[3] = {0.f, 0.f, 0.f}, hv[3] = {0.f, 0.f, 0.f};
    float S[64];
#pragma unroll
    for (int d = 0; d < 64; ++d) S[d] = 0.f;
    const float Aexp = __expf(a.a_log[h]), dtb = a.dt_bias[h];
    const bf16* pr = P + rowof(b, NPAD) * NIN;
    unsigned short nq0 = pr[cq0], nq1 = pr[cq1], nk0 = pr[ck0], nk1 = pr[ck1], nv = pr[cv], nb = pr[C_BETA + h], na = pr[C_A + h];
    const LAS f32x4* kq = (const LAS f32x4*)(sw + 128 + 64 * dh); const LAS f32x4* qq4 = (const LAS f32x4*)(sw + 64 * dh);
    for (int t = NPAD; t < TTOT; ++t) {
        const float xq0 = bf2f(nq0), xq1 = bf2f(nq1), xk0 = bf2f(nk0), xk1 = bf2f(nk1), xv = bf2f(nv), db = bf2f(nb), da = bf2f(na);
        if (t + 1 < TTOT) { pr = P + rowof(b, t + 1) * NIN; nq0 = pr[cq0]; nq1 = pr[cq1]; nk0 = pr[ck0]; nk1 = pr[ck1]; nv = pr[cv]; nb = pr[C_BETA + h]; na = pr[C_A + h]; }
        float q0 = siluf_(wq0[0] * hq0[0] + wq0[1] * hq0[1] + wq0[2] * hq0[2] + wq0[3] * xq0); hq0[0] = hq0[1]; hq0[1] = hq0[2]; hq0[2] = xq0;
        float q1 = siluf_(wq1[0] * hq1[0] + wq1[1] * hq1[1] + wq1[2] * hq1[2] + wq1[3] * xq1); hq1[0] = hq1[1]; hq1[1] = hq1[2]; hq1[2] = xq1;
        float k0 = siluf_(wk0[0] * hk0[0] + wk0[1] * hk0[1] + wk0[2] * hk0[2] + wk0[3] * xk0); hk0[0] = hk0[1]; hk0[1] = hk0[2]; hk0[2] = xk0;
        float k1 = siluf_(wk1[0] * hk1[0] + wk1[1] * hk1[1] + wk1[2] * hk1[2] + wk1[3] * xk1); hk1[0] = hk1[1]; hk1[1] = hk1[2]; hk1[2] = xk1;
        const float v = siluf_(wv[0] * hv[0] + wv[1] * hv[1] + wv[2] * hv[2] + wv[3] * xv); hv[0] = hv[1]; hv[1] = hv[2]; hv[2] = xv;
        const float rq = rsqrtf(wave_sum(q0 * q0 + q1 * q1) + EPS) * 0.08838834764831845f, rk = rsqrtf(wave_sum(k0 * k0 + k1 * k1) + EPS);
        sw[lane] = q0 * rq; sw[64 + lane] = q1 * rq; sw[128 + lane] = k0 * rk; sw[192 + lane] = k1 * rk;
        LDS_WAIT();
        const float beta = sigmoidf_(db), av = __expf(-Aexp * softplusf_(da + dtb));
        float kS = 0.f;
#pragma unroll
        for (int d4 = 0; d4 < 16; ++d4) { const f32x4 kk = kq[d4];
            kS += kk.x * S[4 * d4] + kk.y * S[4 * d4 + 1] + kk.z * S[4 * d4 + 2] + kk.w * S[4 * d4 + 3]; }
        kS += __shfl_xor(kS, 32);
        const float c = beta * (v - av * kS);
        float o = 0.f;
#pragma unroll
        for (int d4 = 0; d4 < 16; ++d4) { const f32x4 kk = kq[d4], qq = qq4[d4];
            S[4 * d4] = kk.x * c + av * S[4 * d4]; S[4 * d4 + 1] = kk.y * c + av * S[4 * d4 + 1]; S[4 * d4 + 2] = kk.z * c + av * S[4 * d4 + 2]; S[4 * d4 + 3] = kk.w * c + av * S[4 * d4 + 3];
            o += qq.x * S[4 * d4] + qq.y * S[4 * d4 + 1] + qq.z * S[4 * d4 + 2] + qq.w * S[4 * d4 + 3]; }
        o += __shfl_xor(o, 32);
        if (t >= CH && dh == 0) O[(size_t)(b * SEQ + t - CH) * D + h * 128 + e] = (bf16)f2bf(o);
        LDS_WAIT();
    }
}
__device__ __forceinline__ void gla_scan_naive(const Args& a, int unit, LAS float* sw, int lane) {
    const int b = unit >> 3, h = (unit >> 1) & 3, half = unit & 1, e = half * 64 + lane;
    const bf16* P = (const bf16*)(a.ws + WS_P); bf16* O = (bf16*)(a.ws + WS_MIX);
    const int cq = C_GQ + h * 64 + lane, ck = C_GK + h * 64 + lane, cv = C_GV + h * 128 + e;
    float w2[16];
#pragma unroll
    for (int r = 0; r < 16; ++r) w2[r] = a.gla_w2[r * 256 + h * 64 + lane];
    const float bias = a.gla_b[h * 64 + lane];
    float S[64];
#pragma unroll
    for (int d = 0; d < 64; ++d) S[d] = 0.f;
    for (int t = NPAD; t < TTOT; ++t) {
        const bf16* pr = P + rowof(b, t) * NIN;
        const float q = bf2f(pr[cq]), k = bf2f(pr[ck]), v = bf2f(pr[cv]);
        const v4u l0 = *(const v4u*)(pr + C_LR), l1 = *(const v4u*)(pr + C_LR + 8);
        float x = bias;
        x += bflo(l0.x) * w2[0] + bfhi(l0.x) * w2[1] + bflo(l0.y) * w2[2] + bfhi(l0.y) * w2[3] + bflo(l0.z) * w2[4] + bfhi(l0.z) * w2[5] + bflo(l0.w) * w2[6] + bfhi(l0.w) * w2[7];
        x += bflo(l1.x) * w2[8] + bfhi(l1.x) * w2[9] + bflo(l1.y) * w2[10] + bfhi(l1.y) * w2[11] + bflo(l1.z) * w2[12] + bfhi(l1.z) * w2[13] + bflo(l1.w) * w2[14] + bfhi(l1.w) * w2[15];
        const float al = __expf(logsigmoidf_(x) * (1.f / 16.f));
        sw[lane] = q * 0.125f; sw[64 + lane] = k; sw[128 + lane] = al;
        LDS_WAIT();
        float o = 0.f;
#pragma unroll
        for (int d4 = 0; d4 < 16; ++d4) { const f32x4 qq = ((const LAS f32x4*)sw)[d4], kk = ((const LAS f32x4*)(sw + 64))[d4], aa = ((const LAS f32x4*)(sw + 128))[d4];
            S[4 * d4] = aa.x * S[4 * d4] + kk.x * v; S[4 * d4 + 1] = aa.y * S[4 * d4 + 1] + kk.y * v; S[4 * d4 + 2] = aa.z * S[4 * d4 + 2] + kk.z * v; S[4 * d4 + 3] = aa.w * S[4 * d4 + 3] + kk.w * v;
            o += qq.x * S[4 * d4] + qq.y * S[4 * d4 + 1] + qq.z * S[4 * d4 + 2] + qq.w * S[4 * d4 + 3]; }
        if (t >= CH) O[(size_t)(b * SEQ + t - CH) * D + 512 + h * 128 + e] = (bf16)f2bf(o);
        LDS_WAIT();
    }
}
__device__ __forceinline__ void norm_gate_rows(const Args& a, int lane, int wave) {
    const bf16* P = (const bf16*)(a.ws + WS_P); bf16* MIX = (bf16*)(a.ws + WS_MIX);
    const int gw = blockIdx.x * NWAVES + wave, NGW = gridDim.x * NWAVES;
    const int zc = lane < 32 ? C_DZ + 16 * lane : C_GR + 16 * (lane - 32);
    const float* gp = (lane < 32 ? a.dn_norm_g : a.gla_norm_g) + (lane & 7) * 16;
    for (int row = gw; row < MR; row += NGW) {
        v4u* mp = (v4u*)(MIX + (size_t)row * D + 16 * lane); const v4u* zp = (const v4u*)(P + (size_t)row * NIN + zc);
        const v4u m0 = mp[0], m1 = mp[1], z0 = zp[0], z1 = zp[1];
        float o[16], z[16];
        o[0] = bflo(m0.x); o[1] = bfhi(m0.x); o[2] = bflo(m0.y); o[3] = bfhi(m0.y); o[4] = bflo(m0.z); o[5] = bfhi(m0.z); o[6] = bflo(m0.w); o[7] = bfhi(m0.w);
        o[8] = bflo(m1.x); o[9] = bfhi(m1.x); o[10] = bflo(m1.y); o[11] = bfhi(m1.y); o[12] = bflo(m1.z); o[13] = bfhi(m1.z); o[14] = bflo(m1.w); o[15] = bfhi(m1.w);
        z[0] = bflo(z0.x); z[1] = bfhi(z0.x); z[2] = bflo(z0.y); z[3] = bfhi(z0.y); z[4] = bflo(z0.z); z[5] = bfhi(z0.z); z[6] = bflo(z0.w); z[7] = bfhi(z0.w);
        z[8] = bflo(z1.x); z[9] = bfhi(z1.x); z[10] = bflo(z1.y); z[11] = bfhi(z1.y); z[12] = bflo(z1.z); z[13] = bfhi(z1.z); z[14] = bflo(z1.w); z[15] = bfhi(z1.w);
        float ss = 0.f;
#pragma unroll
        for (int i = 0; i < 16; ++i) ss += o[i] * o[i];
        ss += __shfl_xor(ss, 1); ss += __shfl_xor(ss, 2); ss += __shfl_xor(ss, 4);
        const float rstd = rsqrtf(ss * (1.f / 128.f) + EPS);
        float r[16];
#pragma unroll
        for (int i = 0; i < 16; ++i) r[i] = o[i] * rstd * gp[i] * siluf_(z[i]);
        v4u w0, w1; w0.x = pk2(r[0], r[1]); w0.y = pk2(r[2], r[3]); w0.z = pk2(r[4], r[5]); w0.w = pk2(r[6], r[7]); w1.x = pk2(r[8], r[9]); w1.y = pk2(r[10], r[11]); w1.z = pk2(r[12], r[13]); w1.w = pk2(r[14], r[15]);
        mp[0] = w0; mp[1] = w1;
    }
}

__global__ void __launch_bounds__(NTHREADS) hymba_fwd(Args a) {
    extern __shared__ __attribute__((aligned(16))) unsigned char lds_raw[];
    cg::grid_group grid = cg::this_grid();
    LAS unsigned char* lds = (LAS unsigned char*)lds_raw;
    const int tid = threadIdx.x, lane = tid & 63, wave = __builtin_amdgcn_readfirstlane(tid >> 6);
    const int G = gridDim.x, gw = blockIdx.x * NWAVES + wave, NGW = G * NWAVES;
    unsigned char* ws = a.ws;
    bf16* Win_t = (bf16*)(ws + WS_WIN); bf16* Wout_t = (bf16*)(ws + WS_WOUT); bf16* Wup_t = (bf16*)(ws + WS_WUP); bf16* Wdn_t = (bf16*)(ws + WS_WDN);
    bf16* HN = (bf16*)(ws + WS_HN); bf16* MIX = (bf16*)(ws + WS_MIX); bf16* P = (bf16*)(ws + WS_P); bf16* H = P;

    p0_prologue(a, lds, tid, lane, wave);
    grid.sync();
    { pg8::Gemm g{HN, Win_t, MR, NIN, D}; pg8::StaticOrder S; S.init(MR, NIN, G, (int)blockIdx.x);
      pg8::EpiBf16<0> E{P, NIN, nullptr, 0, 0, 1.f};
      pg8::gemm_phase<pg8::EpiBf16<0>, pg8::StaticOrder, true, true>(lds, g, S, E); }
    grid.sync();
    if (wave == 0) { LAS float* sw = (LAS float*)lds; for (int u = blockIdx.x; u < 256; u += G) dn_scan_naive(a, u, sw, lane); }
    else if (wave == 1) { LAS float* sw = (LAS float*)(lds + 4096); for (int u = blockIdx.x; u < 128; u += G) gla_scan_naive(a, u, sw, lane); }
    grid.sync();
    norm_gate_rows(a, lane, wave);
    grid.sync();
    { pg8::Gemm g{MIX, Wout_t, MR, D, D}; pg8::StaticOrder S; S.init(MR, D, G, (int)blockIdx.x);
      pg8::EpiResF32 E{a.x, a.out, D};
      pg8::gemm_phase<pg8::EpiResF32, pg8::StaticOrder, true, true>(lds, g, S, E); }
    grid.sync();
    for (int m = gw; m < MR; m += NGW) rms_row_to_bf16(a.out + (size_t)m * D, a.norm2_g, HN + (size_t)m * D, lane);
    grid.sync();
    { pg8::Gemm g{HN, Wup_t, MR, FF, D}; pg8::StaticOrder S; S.init(MR, FF, G, (int)blockIdx.x);
      pg8::EpiRelu2Bf16 E{H, FF};
      pg8::gemm_phase<pg8::EpiRelu2Bf16, pg8::StaticOrder, true, true>(lds, g, S, E); }
    grid.sync();
    { pg8::Gemm g{H, Wdn_t, MR, D, FF}; pg8::StaticOrder S; S.init(MR, D, G, (int)blockIdx.x);
      pg8::EpiResF32 E{a.out, a.out, D};
      pg8::gemm_phase<pg8::EpiResF32, pg8::StaticOrder, true, true>(lds, g, S, E); }
    grid.sync();
    for (int m = gw; m < MR; m += NGW) rms_row_f32(a.out + (size_t)m * D, a.final_g, lane);
}

extern "C" void kernel_launch(void* const* d_in, const int* in_sizes, int n_in, void* d_out, int out_size, void* d_ws, size_t ws_size, hipStream_t stream) {
    static int grid = 0;
    if (grid == 0) {
        int dev = 0, cus = 0, per_cu = 0;
        hipGetDevice(&dev); hipDeviceGetAttribute(&cus, hipDeviceAttributeMultiprocessorCount, dev);
        hipFuncSetAttribute((const void*)hymba_fwd, hipFuncAttributeMaxDynamicSharedMemorySize, LDS_BYTES);
        hipOccupancyMaxActiveBlocksPerMultiprocessor(&per_cu, (const void*)hymba_fwd, NTHREADS, LDS_BYTES);
        if (per_cu < 1) per_cu = 1;
        grid = cus * (per_cu > 1 ? 1 : per_cu);
        (void)hipGetLastError();
    }
    Args a{};
    a.x = (const float*)d_in[0]; a.meta = (const float*)d_in[1]; a.norm1_g = (const float*)d_in[2]; a.w_in = (const float*)d_in[3]; a.conv_w = (const float*)d_in[4];
    a.a_log = (const float*)d_in[5]; a.dt_bias = (const float*)d_in[6]; a.dn_norm_g = (const float*)d_in[7]; a.gla_w2 = (const float*)d_in[8]; a.gla_b = (const float*)d_in[9];
    a.gla_norm_g = (const float*)d_in[10]; a.w_out = (const float*)d_in[11]; a.norm2_g = (const float*)d_in[12]; a.w_up = (const float*)d_in[13]; a.w_down = (const float*)d_in[14];
    a.final_g = (const float*)d_in[15]; a.out = (float*)d_out; a.ws = (unsigned char*)d_ws;
    void* args[] = {&a};
    hipError_t e = hipLaunchCooperativeKernel((const void*)hymba_fwd, dim3(grid), dim3(NTHREADS), args, LDS_BYTES, stream);
    if (e != hipSuccess) fprintf(stderr, "cooperative launch failed: %s (grid %d)\n", hipGetErrorString(e), grid);
}
```

```cpp
#include <hip/hip_runtime.h>
#include <hip/hip_cooperative_groups.h>
#include <cstdio>
#include <cstdint>
namespace cg = cooperative_groups;
namespace pg8 {
#define PG8_LAS __attribute__((address_space(3)))
typedef unsigned short bf16_t;
typedef short bf16x8 __attribute__((ext_vector_type(8)));
typedef float f32x4 __attribute__((ext_vector_type(4)));
typedef unsigned u32x4 __attribute__((ext_vector_type(4)));
constexpr int BM = 256, BK = 64, HALF = 128, HTB = HALF * BK * 2  , STAGE_BYTES = 8 * HTB, NXCD = 8, WGM = 8;

__host__ __device__ __forceinline__ int lds_byte(int r, int c) { const int st = (r >> 4) * 2 + (c >> 5), rr = r & 15, cc = c & 31, ob = rr * 64 + cc * 2; return st * 1024 + (ob ^ (((ob >> 9) & 1) << 5)); }
__host__ __device__ __forceinline__ void stage_rc(int b, int& R, int& C) { const int st = b / 1024, sb = b % 1024, swz = sb ^ (((sb >> 9) & 1) << 5); R = (st >> 1) * 16 + swz / 64; C = (st & 1) * 32 + (swz % 64) / 2; }
__host__ __device__ __forceinline__ int perm32(int rho) { const int n = rho >> 4, i = rho & 15; return 8 * (i >> 2) + 4 * n + (i & 3); }

struct Unit { int pm, pn; };
struct Gemm { const bf16_t* A; const bf16_t* Bt; int M, N, K; };

struct StaticOrder {
    int nM, nN, nwg, G, c;
    __host__ __device__ void init(int M, int N, int G_, int c_) { nM = M / BM; nN = N / BM; nwg = nM * nN; G = G_; c = c_; }
    __host__ __device__ bool next(int i, Unit& u) const {
        const long L = (long)i * G + c; if (L >= nwg) return false;
        int wgid = (int)L; { const int q = nwg / NXCD, r = nwg % NXCD, xcd = wgid % NXCD, off = wgid / NXCD; wgid = (xcd < r ? xcd * (q + 1) : r * (q + 1) + (xcd - r) * q) + off; }
        const int nig = WGM * nN, gid = wgid / nig, fm = gid * WGM, gsz = (nM - fm) < WGM ? (nM - fm) : WGM;
        u.pm = fm + ((wgid % nig) % gsz); u.pn = (wgid % nig) / gsz; return true;
    }
    __device__ __forceinline__ void a_ready(const Unit&) const {}
    __device__ __forceinline__ void done(const Unit&) const {}
};

typedef float f32x2 __attribute__((ext_vector_type(2)));
typedef __bf16 pg8_bf16v2 __attribute__((ext_vector_type(2)));
__device__ __forceinline__ unsigned cvt_pk_bf16(float lo, float hi) { const f32x2 v = {lo, hi}; const pg8_bf16v2 b = __builtin_convertvector(v, pg8_bf16v2); return __builtin_bit_cast(unsigned, b); }
__device__ __forceinline__ f32x2 gelu_pk(f32x2 v) {
    const f32x2 av = __builtin_elementwise_abs(v), d = av * 0.2316418882f + 1.0f;
    f32x2 t; t.x = __builtin_amdgcn_rcpf(d.x); t.y = __builtin_amdgcn_rcpf(d.y);
    f32x2 q = t * 0.5307027145f + (-0.7265760135f); q = q * t + 0.7107068705f; q = q * t + (-0.142248368f); q = q * t + 0.127414796f; q = q * t;
    const f32x2 s = (v * v) * (-0.72134752044f);
    f32x2 e; e.x = __builtin_amdgcn_exp2f(s.x); e.y = __builtin_amdgcn_exp2f(s.y);
    const f32x2 m = v * (q * e), r = v - m;
    f32x2 o; o.x = v.x < 0.f ? m.x : r.x; o.y = v.y < 0.f ? m.y : r.y; return o;
}

template <int ACT  > struct EpiBf16 {
    static constexpr bool PERM = true, AFTER_DRAIN = false; static_assert(ACT == 0 || ACT == 1, "EpiBf16: ACT is 0 (none) or 1 (gelu_pk)");
    bf16_t* O; int ldc; const float* bias; int split_cols; size_t split_stride; float scale0;
    __device__ __forceinline__ void operator()(const f32x4 (&acc)[2][2][4][2], const Unit& u, int wr, int wc, int fr, int fq) const {
        const int row0 = u.pm * BM + wr * 64 + fr; int colt = u.pn * BM; bf16_t* base = O;
        float sc = 1.f; if (split_cols) { const int t = colt / split_cols; base += (size_t)t * split_stride; colt -= t * split_cols; if (t == 0) sc = scale0; }
        const int col0 = colt + wc * 32 + 8 * fq, bcol0 = u.pn * BM + wc * 32 + 8 * fq;
        f32x4 bv[2][2];
#pragma unroll
        for (int bj = 0; bj < 2; ++bj)
#pragma unroll
            for (int n = 0; n < 2; ++n) bv[bj][n] = bias ? *(const f32x4*)(bias + bcol0 + bj * HALF + 4 * n) : (f32x4){0.f, 0.f, 0.f, 0.f};
#pragma unroll
        for (int ai = 0; ai < 2; ++ai)
#pragma unroll
            for (int m = 0; m < 4; ++m) { bf16_t* rowp = base + (size_t)(row0 + ai * HALF + m * 16) * ldc + col0;
#pragma unroll
                for (int bj = 0; bj < 2; ++bj) { f32x4 v0 = acc[ai][bj][m][0] + bv[bj][0], v1 = acc[ai][bj][m][1] + bv[bj][1];
                    if (ACT == 1) { f32x2 a = gelu_pk((f32x2){v0[0], v0[1]}), b = gelu_pk((f32x2){v0[2], v0[3]}), c = gelu_pk((f32x2){v1[0], v1[1]}), d = gelu_pk((f32x2){v1[2], v1[3]});
                        v0 = (f32x4){a.x, a.y, b.x, b.y}; v1 = (f32x4){c.x, c.y, d.x, d.y}; }
                    v0 = v0 * sc; v1 = v1 * sc; u32x4 w; w.x = cvt_pk_bf16(v0[0], v0[1]); w.y = cvt_pk_bf16(v0[2], v0[3]); w.z = cvt_pk_bf16(v1[0], v1[1]); w.w = cvt_pk_bf16(v1[2], v1[3]);
                    *(u32x4*)(rowp + bj * HALF) = w; } }
    }
};

struct EpiRelu2Bf16 {
    static constexpr bool PERM = true, AFTER_DRAIN = false;
    bf16_t* O; int ldc;
    __device__ __forceinline__ void operator()(const f32x4 (&acc)[2][2][4][2], const Unit& u, int wr, int wc, int fr, int fq) const {
        const int row0 = u.pm * BM + wr * 64 + fr; const int col0 = u.pn * BM + wc * 32 + 8 * fq;
#pragma unroll
        for (int ai = 0; ai < 2; ++ai)
#pragma unroll
            for (int m = 0; m < 4; ++m) { bf16_t* rowp = O + (size_t)(row0 + ai * HALF + m * 16) * ldc + col0;
#pragma unroll
                for (int bj = 0; bj < 2; ++bj) { f32x4 v0 = acc[ai][bj][m][0], v1 = acc[ai][bj][m][1];
#pragma unroll
                    for (int i = 0; i < 4; ++i) { float a0 = v0[i] > 0.f ? v0[i] : 0.f, a1 = v1[i] > 0.f ? v1[i] : 0.f; v0[i] = a0 * a0; v1[i] = a1 * a1; }
                    u32x4 w; w.x = cvt_pk_bf16(v0[0], v0[1]); w.y = cvt_pk_bf16(v0[2], v0[3]); w.z = cvt_pk_bf16(v1[0], v1[1]); w.w = cvt_pk_bf16(v1[2], v1[3]);
                    *(u32x4*)(rowp + bj * HALF) = w; } }
    }
};
struct EpiResF32 {
    static constexpr bool PERM = false, AFTER_DRAIN = false;
    const float* base; float* out; int ldc;
    __device__ __forceinline__ void operator()(const f32x4 (&acc)[2][2][4][2], const Unit& u, int wr, int wc, int fr, int fq) const {
        const int col0 = u.pn * BM + wc * 32 + 4 * fq;
#pragma unroll
        for (int ai = 0; ai < 2; ++ai)
#pragma unroll
            for (int m = 0; m < 4; ++m) { const size_t off = (size_t)(u.pm * BM + ai * HALF + wr * 64 + m * 16 + fr) * ldc + col0;
#pragma unroll
                for (int bj = 0; bj < 2; ++bj)
#pragma unroll
                    for (int n = 0; n < 2; ++n) { const f32x4 bs = *(const f32x4*)(base + off + bj * HALF + n * 16); *(f32x4*)(out + off + bj * HALF + n * 16) = bs + acc[ai][bj][m][n]; } }
    }
};
typedef unsigned u32x2 __attribute__((ext_vector_type(2)));
template <bool BASE_BF16> struct EpiResStats {
    static constexpr bool PERM = false, AFTER_DRAIN = false;
    const void* base; bf16_t* ob; float* PS; int ldc;
    __device__ __forceinline__ void operator()(const f32x4 (&acc)[2][2][4][2], const Unit& u, int wr, int wc, int fr, int fq) const {
        const int col0 = u.pn * BM + wc * 32 + 4 * fq;
#pragma unroll
        for (int ai = 0; ai < 2; ++ai)
#pragma unroll
            for (int m = 0; m < 4; ++m) { const int row = u.pm * BM + ai * HALF + wr * 64 + m * 16 + fr; const size_t off = (size_t)row * ldc + col0; float sq = 0.f;
                f32x4 bs[2][2];
#pragma unroll
                for (int bj = 0; bj < 2; ++bj)
#pragma unroll
                    for (int n = 0; n < 2; ++n) {
                        if (BASE_BF16) { const u32x2 w = *(const u32x2*)((const bf16_t*)base + off + bj * HALF + n * 16);
                            bs[bj][n] = (f32x4){__builtin_bit_cast(float, w.x << 16), __builtin_bit_cast(float, w.x & 0xffff0000u), __builtin_bit_cast(float, w.y << 16), __builtin_bit_cast(float, w.y & 0xffff0000u)}; }
                        else bs[bj][n] = *(const f32x4*)((const float*)base + off + bj * HALF + n * 16); }
#pragma unroll
                for (int bj = 0; bj < 2; ++bj)
#pragma unroll
                    for (int n = 0; n < 2; ++n) { const f32x4 v = bs[bj][n] + acc[ai][bj][m][n]; sq += (v[0] * v[0] + v[1] * v[1]) + (v[2] * v[2] + v[3] * v[3]);
                        u32x2 w; w.x = cvt_pk_bf16(v[0], v[1]); w.y = cvt_pk_bf16(v[2], v[3]); *(u32x2*)(ob + off + bj * HALF + n * 16) = w; }
                sq += __shfl_xor(sq, 16); sq += __shfl_xor(sq, 32);
                if (fq == 0) PS[(size_t)row * 16 + u.pn * 4 + wc] = sq; }
    }
};
struct EpiRelu2Scaled {
    static constexpr bool PERM = true, AFTER_DRAIN = false;
    bf16_t* O; int ldc; const float* PS;
    __device__ __forceinline__ void operator()(const f32x4 (&acc)[2][2][4][2], const Unit& u, int wr, int wc, int fr, int fq) const {
        const int row0 = u.pm * BM + wr * 64 + fr; const int col0 = u.pn * BM + wc * 32 + 8 * fq;
        float rs[2][4];
#pragma unroll
        for (int ai = 0; ai < 2; ++ai)
#pragma unroll
            for (int m = 0; m < 4; ++m) { const f32x4* pp = (const f32x4*)(PS + (size_t)(row0 + ai * HALF + m * 16) * 16); const f32x4 a0 = pp[0], a1 = pp[1], a2 = pp[2], a3 = pp[3];
                const float s = ((a0[0] + a0[1]) + (a0[2] + a0[3])) + ((a1[0] + a1[1]) + (a1[2] + a1[3])) + ((a2[0] + a2[1]) + (a2[2] + a2[3])) + ((a3[0] + a3[1]) + (a3[2] + a3[3]));
                rs[ai][m] = __builtin_amdgcn_rsqf(s * (1.0f / 1024.0f) + 1e-6f); }
#pragma unroll
        for (int ai = 0; ai < 2; ++ai)
#pragma unroll
            for (int m = 0; m < 4; ++m) { bf16_t* rowp = O + (size_t)(row0 + ai * HALF + m * 16) * ldc + col0; const float r = rs[ai][m];
#pragma unroll
                for (int bj = 0; bj < 2; ++bj) { f32x4 v0 = acc[ai][bj][m][0] * r, v1 = acc[ai][bj][m][1] * r;
#pragma unroll
                    for (int i = 0; i < 4; ++i) { float a0 = v0[i] > 0.f ? v0[i] : 0.f, a1 = v1[i] > 0.f ? v1[i] : 0.f; v0[i] = a0 * a0; v1[i] = a1 * a1; }
                    u32x4 w; w.x = cvt_pk_bf16(v0[0], v0[1]); w.y = cvt_pk_bf16(v0[2], v0[3]); w.z = cvt_pk_bf16(v1[0], v1[1]); w.w = cvt_pk_bf16(v1[2], v1[3]);
                    *(u32x4*)(rowp + bj * HALF) = w; } }
    }
};
struct EpiBf16Blocked {
    static constexpr bool PERM = true, AFTER_DRAIN = false;
    bf16_t* O; int ncb;
    __device__ __forceinline__ void operator()(const f32x4 (&acc)[2][2][4][2], const Unit& u, int wr, int wc, int fr, int fq) const {
        const int row0 = u.pm * BM + wr * 64 + fr; const int col0 = u.pn * BM + wc * 32 + 8 * fq;
#pragma unroll
        for (int ai = 0; ai < 2; ++ai)
#pragma unroll
            for (int m = 0; m < 4; ++m) { const int row = row0 + ai * HALF + m * 16;
#pragma unroll
                for (int bj = 0; bj < 2; ++bj) { const int col = col0 + bj * HALF; const f32x4 v0 = acc[ai][bj][m][0], v1 = acc[ai][bj][m][1];
                    u32x4 w; w.x = cvt_pk_bf16(v0[0], v0[1]); w.y = cvt_pk_bf16(v0[2], v0[3]); w.z = cvt_pk_bf16(v1[0], v1[1]); w.w = cvt_pk_bf16(v1[2], v1[3]);
                    *(u32x4*)(O + ((((size_t)(row >> 6) * ncb + (col >> 6)) * 64 + (row & 63)) * 64 + (col & 63))) = w; } }
    }
};
template <class Epi, class Sched, bool ALIGN_EPI = false, bool SP2 = false>
__device__ __forceinline__ void gemm_phase(PG8_LAS unsigned char* lds, const Gemm g, const Sched& S, const Epi& E) {
    int tid_ = threadIdx.x; asm volatile("" : "+v"(tid_)); const int tid = tid_, wid = __builtin_amdgcn_readfirstlane(tid >> 6), lane = tid & 63, wr = wid >> 2, wc = wid & 3, fr = lane & 15, fq = lane >> 4;
    const int K = g.K, nt = K / BK;
    unsigned voffA[2], voffB[2];
#pragma unroll
    for (int i = 0; i < 2; ++i) { int R, C; stage_rc(tid * 16 + i * 8192, R, C); const int Rb = Epi::PERM ? ((R & ~31) + perm32(R & 31)) : R;
        voffA[i] = (unsigned)(R * K + C) * 2u; voffB[i] = (unsigned)(Rb * K + C) * 2u; }
    const size_t kstep = (size_t)(BK * 2);
    const size_t hstep = (size_t)HALF * K * 2;
    const size_t tstep = 2 * hstep;
    const unsigned ldsw = (unsigned)wid * 1024u;
    const int aoff = lds_byte(wr * 64 + fr, fq * 8), boff = lds_byte(wc * 32 + fr, fq * 8);
#define PG8_SA(b, h) (((b) * 2 + (h)) * HTB)
#define PG8_SB(b, h) ((4 + (b) * 2 + (h)) * HTB)
#define PG8_STAGE(bufoff, gbase, voff) do { _Pragma("unroll") for (int _i = 0; _i < 2; ++_i) \
        __builtin_amdgcn_global_load_lds((const unsigned*)((const char*)(gbase) + (voff)[_i]), (PG8_LAS unsigned*)(lds + (bufoff) + ldsw + _i * 8192), 16, 0, 0); } while (0)
#define PG8_LDA(dst, b, h) do { _Pragma("unroll") for (int m = 0; m < 4; ++m) _Pragma("unroll") for (int k = 0; k < 2; ++k) dst[m][k] = *(const PG8_LAS bf16x8*)(lds + PG8_SA(b, h) + aoff + m * 2048 + k * 1024); } while (0)
#define PG8_LDB(dst, b, h) do { _Pragma("unroll") for (int n = 0; n < 2; ++n) _Pragma("unroll") for (int k = 0; k < 2; ++k) dst[n][k] = *(const PG8_LAS bf16x8*)(lds + PG8_SB(b, h) + boff + n * 2048 + k * 1024); } while (0)
#define PG8_MMA(ai, bj, At, Bt) do { __builtin_amdgcn_s_setprio(1); _Pragma("unroll") for (int m = 0; m < 4; ++m) _Pragma("unroll") for (int n = 0; n < 2; ++n) _Pragma("unroll") for (int k = 0; k < 2; ++k) \
        acc[ai][bj][m][n] = __builtin_amdgcn_mfma_f32_16x16x32_bf16(Bt[n][k], At[m][k], acc[ai][bj][m][n], 0, 0, 0); __builtin_amdgcn_s_setprio(0); } while (0)
#define PG8_WAIT_V(n) asm volatile("s_waitcnt vmcnt(" #n ")" ::: "memory")
#define PG8_WAIT_L(n) asm volatile("s_waitcnt lgkmcnt(" #n ")" ::: "memory")
#define PG8_BAR __builtin_amdgcn_s_barrier()
#define PG8_SCHED __builtin_amdgcn_sched_barrier(0)
    Unit cur, nxt; int ui = 0;
    if (!S.next(0, cur)) return;
    f32x4 acc[2][2][4][2];
#pragma unroll
    for (int a = 0; a < 2; ++a)
#pragma unroll
        for (int b = 0; b < 2; ++b)
#pragma unroll
            for (int m = 0; m < 4; ++m)
#pragma unroll
                for (int n = 0; n < 2; ++n) acc[a][b][m][n] = (f32x4){0.f, 0.f, 0.f, 0.f};
    bf16x8 At[4][2], B0[2][2], B1[2][2];
    const char* cA = (const char*)g.A + (size_t)cur.pm * tstep; const char* cB = (const char*)g.Bt + (size_t)cur.pn * tstep;
    S.a_ready(cur);
    if constexpr (SP2) {
        PG8_STAGE(PG8_SB(0, 0), cB, voffB); PG8_STAGE(PG8_SB(0, 1), cB + hstep, voffB); PG8_STAGE(PG8_SA(0, 0), cA, voffA); PG8_STAGE(PG8_SA(0, 1), cA + hstep, voffA);
        if (wr == 1) PG8_BAR;
        PG8_WAIT_V(2); PG8_BAR;
        PG8_STAGE(PG8_SB(1, 0), cB + kstep, voffB); PG8_STAGE(PG8_SA(1, 0), cA + kstep, voffA); PG8_STAGE(PG8_SB(1, 1), cB + hstep + kstep, voffB);
        PG8_WAIT_V(6); PG8_BAR;
    } else {
        PG8_STAGE(PG8_SB(0, 0), cB, voffB); PG8_STAGE(PG8_SA(0, 0), cA, voffA); PG8_STAGE(PG8_SB(0, 1), cB + hstep, voffB); PG8_STAGE(PG8_SA(0, 1), cA + hstep, voffA);
        if (wr == 1) PG8_BAR;
        PG8_WAIT_V(4); PG8_BAR;
        PG8_STAGE(PG8_SB(1, 0), cB + kstep, voffB); PG8_STAGE(PG8_SA(1, 0), cA + kstep, voffA); PG8_STAGE(PG8_SB(1, 1), cB + hstep + kstep, voffB);
        PG8_WAIT_V(6); PG8_BAR;
    }
    for (;;) {
        const bool has_next = S.next(ui + 1, nxt);
        const char* nA = has_next ? (const char*)g.A + (size_t)nxt.pm * tstep : cA; const char* nB = has_next ? (const char*)g.Bt + (size_t)nxt.pn * tstep : cB;
        for (int t = 0; t < nt; t += 2) {
            const bool last = (t == nt - 2);
            const char* a1 = cA + (size_t)(t + 1) * kstep;
            const char* a2 = last ? nA : cA + (size_t)(t + 2) * kstep; const char* b2 = last ? nB : cB + (size_t)(t + 2) * kstep;
            const char* a3 = a2 + kstep; const char* b3 = b2 + kstep;
            if (last && has_next) S.a_ready(nxt);
            if constexpr (SP2) {
            PG8_LDB(B0, 0, 0); PG8_LDB(B1, 0, 1); PG8_SCHED; PG8_LDA(At, 0, 0); PG8_STAGE(PG8_SA(1, 1), a1 + hstep, voffA);
            PG8_WAIT_V(8); PG8_WAIT_L(0); PG8_BAR; PG8_MMA(0, 0, At, B0); PG8_MMA(0, 1, At, B1); PG8_BAR; PG8_SCHED;
            PG8_LDA(At, 0, 1); PG8_STAGE(PG8_SB(0, 0), b2, voffB); PG8_STAGE(PG8_SB(0, 1), b2 + hstep, voffB); PG8_STAGE(PG8_SA(0, 0), a2, voffA);
            PG8_WAIT_V(8); PG8_WAIT_L(0); PG8_BAR; PG8_MMA(1, 0, At, B0); PG8_MMA(1, 1, At, B1); PG8_BAR; PG8_SCHED;
            PG8_LDB(B0, 1, 0); PG8_LDB(B1, 1, 1); PG8_SCHED; PG8_LDA(At, 1, 0); PG8_STAGE(PG8_SA(0, 1), a2 + hstep, voffA);
            PG8_WAIT_V(8); PG8_WAIT_L(0); PG8_BAR; PG8_MMA(0, 0, At, B0); PG8_MMA(0, 1, At, B1); PG8_BAR; PG8_SCHED;
            PG8_LDA(At, 1, 1); PG8_STAGE(PG8_SB(1, 0), b3, voffB); PG8_STAGE(PG8_SB(1, 1), b3 + hstep, voffB); PG8_STAGE(PG8_SA(1, 0), a3, voffA);
            PG8_WAIT_V(8); PG8_WAIT_L(0); PG8_BAR; PG8_MMA(1, 0, At, B0); PG8_MMA(1, 1, At, B1); PG8_BAR; PG8_SCHED;
            } else {
            PG8_LDB(B0, 0, 0); PG8_SCHED; PG8_LDA(At, 0, 0); PG8_STAGE(PG8_SA(1, 1), a1 + hstep, voffA);
            PG8_WAIT_L(8); PG8_BAR; PG8_WAIT_L(0); PG8_MMA(0, 0, At, B0); PG8_BAR; PG8_SCHED;
            PG8_LDB(B1, 0, 1); PG8_STAGE(PG8_SB(0, 0), b2, voffB);
            PG8_BAR; PG8_WAIT_L(0); PG8_MMA(0, 1, At, B1); PG8_BAR;
            PG8_LDA(At, 0, 1); PG8_STAGE(PG8_SA(0, 0), a2, voffA);
            PG8_BAR; PG8_WAIT_L(0); PG8_MMA(1, 0, At, B0); PG8_BAR; PG8_SCHED;
            PG8_STAGE(PG8_SB(0, 1), b2 + hstep, voffB);
            PG8_WAIT_V(6); PG8_BAR; PG8_MMA(1, 1, At, B1); PG8_BAR;
            PG8_LDB(B0, 1, 0); PG8_SCHED; PG8_LDA(At, 1, 0); PG8_STAGE(PG8_SA(0, 1), a2 + hstep, voffA);
            PG8_WAIT_L(8); PG8_BAR; PG8_WAIT_L(0); PG8_MMA(0, 0, At, B0); PG8_BAR; PG8_SCHED;
            PG8_LDB(B1, 1, 1); PG8_STAGE(PG8_SB(1, 0), b3, voffB);
            PG8_BAR; PG8_WAIT_L(0); PG8_MMA(0, 1, At, B1); PG8_BAR;
            PG8_LDA(At, 1, 1); PG8_STAGE(PG8_SA(1, 0), a3, voffA);
            PG8_BAR; PG8_WAIT_L(0); PG8_MMA(1, 0, At, B0); PG8_BAR; PG8_SCHED;
            PG8_STAGE(PG8_SB(1, 1), b3 + hstep, voffB);
            PG8_WAIT_V(6); PG8_BAR; PG8_MMA(1, 1, At, B1); PG8_BAR;
            }
        }
        if constexpr (ALIGN_EPI) { if (wr == 0) PG8_BAR; }
        if constexpr (!Epi::AFTER_DRAIN) { E(acc, cur, wr, wc, fr, fq); S.done(cur); }
        if (!has_next) break;
#pragma unroll
        for (int a = 0; a < 2; ++a)
#pragma unroll
            for (int b = 0; b < 2; ++b)
#pragma unroll
                for (int m = 0; m < 4; ++m)
#pragma unroll
                    for (int n = 0; n < 2; ++n) acc[a][b][m][n] = (f32x4){0.f, 0.f, 0.f, 0.f};
        cur = nxt; cA = nA; cB = nB; ++ui;
        if constexpr (ALIGN_EPI) { if (wr == 1) PG8_BAR; }
    }
    PG8_WAIT_V(0);
    if constexpr (!ALIGN_EPI) { if (wr == 0) PG8_BAR; }
    PG8_BAR;
    if constexpr (Epi::AFTER_DRAIN) { E.fused(acc, cur, wr, wc, fr, fq, lds, wid, lane); S.done(cur); }
#undef PG8_SA
#undef PG8_SB
#undef PG8_STAGE
#undef PG8_LDA
#undef PG8_LDB
#undef PG8_MMA
#undef PG8_WAIT_V
#undef PG8_WAIT_L
#undef PG8_BAR
#undef PG8_SCHED
}
}
#define LAS __attribute__((address_space(3)))
typedef unsigned short bf16;
typedef float f32x4 __attribute__((ext_vector_type(4)));
typedef unsigned v4u __attribute__((ext_vector_type(4)));
typedef unsigned v2u __attribute__((ext_vector_type(2)));
#define LDS_WAIT() asm volatile("s_waitcnt lgkmcnt(0)" ::: "memory")

constexpr int NWAVES = 8, NTHREADS = 512;
constexpr int BATCH = 16, SEQ = 4096, D = 1024, FF = 4096, CH = 64, TTOT = SEQ + CH, NPAD = 48;
constexpr int MR = BATCH * SEQ;
constexpr int PROWS = MR + CH;
constexpr int NIN = 3840, NIN_SRC = 3608;
constexpr int C_DQ = 0, C_DK = 512, C_DV = 1024, C_DZ = 1536, C_GQ = 2048, C_GK = 2304, C_GV = 2560, C_GR = 3072, C_BETA = 3584, C_A = 3588, C_LR = 3592;
constexpr float EPS = 1e-6f;
constexpr size_t MiB = 1u << 20;
constexpr size_t WS_WIN = 0, WS_WOUT = 8 * MiB, WS_WUP = 10 * MiB, WS_WDN = 18 * MiB, WS_HN = 32 * MiB, WS_MIX = 160 * MiB, WS_P = 288 * MiB;
constexpr size_t WS_PS1 = 976 * MiB, WS_PS2 = 982 * MiB;
constexpr int LDS_BYTES = 147456;

struct Args {
    const float *x, *meta, *norm1_g, *w_in, *conv_w, *a_log, *dt_bias, *dn_norm_g, *gla_w2, *gla_b, *gla_norm_g, *w_out, *norm2_g, *w_up, *w_down, *final_g;
    float* out; unsigned char* ws;
};

typedef __bf16 bf16v2_t __attribute__((ext_vector_type(2)));
typedef float f32v2_t __attribute__((ext_vector_type(2)));
__device__ __forceinline__ unsigned pk2(float lo, float hi) { const f32v2_t v = {lo, hi}; const bf16v2_t b = __builtin_convertvector(v, bf16v2_t); return __builtin_bit_cast(unsigned, b); }
__device__ __forceinline__ unsigned f2bf(float f) { return pk2(f, 0.f) & 0xffffu; }
__device__ __forceinline__ float bf2f(unsigned short h) { return __builtin_bit_cast(float, (unsigned)h << 16); }
__device__ __forceinline__ float bflo(unsigned w) { return __builtin_bit_cast(float, w << 16); }
__device__ __forceinline__ float bfhi(unsigned w) { return __builtin_bit_cast(float, w & 0xffff0000u); }
__device__ __forceinline__ float wave_sum(float v) {
#pragma unroll
    for (int o = 1; o < 64; o <<= 1) v += __shfl_xor(v, o);
    return v;
}
__device__ __forceinline__ float sigmoidf_(float x) { return __builtin_amdgcn_rcpf(1.f + __expf(-x)); }
__device__ __forceinline__ float siluf_(float x) { return x * __builtin_amdgcn_rcpf(1.f + __expf(-x)); }
__device__ __forceinline__ float softplusf_(float x) { return fmaxf(x, 0.f) + __logf(1.f + __expf(-fabsf(x))); }
__device__ __forceinline__ float logsigmoidf_(float x) { return fminf(x, 0.f) - __logf(1.f + __expf(-fabsf(x))); }
__device__ __forceinline__ size_t rowof(int b, int t) { return t < CH ? (size_t)(MR + t) : (size_t)(b * SEQ + t - CH); }

__device__ __forceinline__ int win_src(int n) { return n < 2048 ? n : (n < 3584 ? n + 8 : (n < 3592 ? n - 1536 : (n < 3608 ? n : -1))); }

template <bool MAP> __device__ __forceinline__ void transpose_item(const float* W, int K, int Nsrc, bf16* WT, LAS float* scr, int kb, int nb, int lane, const float* kscale = nullptr) {
    const int k0 = 64 * kb, n0 = 32 * nb;
    const int nn = n0 + (lane & 31); const int src = MAP ? win_src(nn) : nn;
#pragma unroll
    for (int i = 0; i < 32; ++i) { const int kk = 2 * i + (lane >> 5); float wv = src >= 0 ? W[(size_t)(k0 + kk) * Nsrc + src] : 0.f; if (kscale) wv *= kscale[k0 + kk]; scr[kk * 33 + (lane & 31)] = wv; }
    LDS_WAIT();
    const int c = lane & 7;
#pragma unroll
    for (int j = 0; j < 4; ++j) { const int n = (lane >> 3) + 8 * j; const LAS float* s = scr + (8 * c) * 33 + n;
        v4u o; o.x = pk2(s[0 * 33], s[1 * 33]); o.y = pk2(s[2 * 33], s[3 * 33]); o.z = pk2(s[4 * 33], s[5 * 33]); o.w = pk2(s[6 * 33], s[7 * 33]);
        *(v4u*)(WT + (size_t)(n0 + n) * K + k0 + 8 * c) = o; }
    LDS_WAIT();
}
__device__ __forceinline__ void rms_row_to_bf16(const float* xrow, const float* g, bf16* orow, int lane) {
    const f32x4* xr = (const f32x4*)xrow + lane; f32x4 v[4]; float s = 0.f;
#pragma unroll
    for (int j = 0; j < 4; ++j) { v[j] = xr[64 * j]; s += (v[j].x * v[j].x + v[j].y * v[j].y) + (v[j].z * v[j].z + v[j].w * v[j].w); }
    const float rstd = rsqrtf(wave_sum(s) * (1.f / D) + EPS);
    unsigned long long* o8 = (unsigned long long*)orow + lane;
#pragma unroll
    for (int j = 0; j < 4; ++j) { const f32x4 gv = ((const f32x4*)g)[lane + 64 * j];
        o8[64 * j] = (unsigned long long)pk2(v[j].x * rstd * gv.x, v[j].y * rstd * gv.y) | ((unsigned long long)pk2(v[j].z * rstd * gv.z, v[j].w * rstd * gv.w) << 32); }
}
__device__ __forceinline__ void final_row(const bf16* yrow, const float* ps, const f32x4 g0, const f32x4 g1, const f32x4 g2, const f32x4 g3, float* orow, int lane) {
    const f32x4 p0 = ((const f32x4*)ps)[0], p1 = ((const f32x4*)ps)[1], p2 = ((const f32x4*)ps)[2], p3 = ((const f32x4*)ps)[3];
    const float s = ((p0[0] + p0[1]) + (p0[2] + p0[3])) + ((p1[0] + p1[1]) + (p1[2] + p1[3])) + ((p2[0] + p2[1]) + (p2[2] + p2[3])) + ((p3[0] + p3[1]) + (p3[2] + p3[3]));
    const float rstd = rsqrtf(s * (1.f / D) + EPS);
    const v4u y0 = ((const v4u*)yrow)[lane], y1 = ((const v4u*)yrow)[lane + 64];
    f32x4* op = (f32x4*)orow;
    op[2 * lane] = (f32x4){bflo(y0.x), bfhi(y0.x), bflo(y0.y), bfhi(y0.y)} * rstd * g0; op[2 * lane + 1] = (f32x4){bflo(y0.z), bfhi(y0.z), bflo(y0.w), bfhi(y0.w)} * rstd * g1;
    op[128 + 2 * lane] = (f32x4){bflo(y1.x), bfhi(y1.x), bflo(y1.y), bfhi(y1.y)} * rstd * g2; op[128 + 2 * lane + 1] = (f32x4){bflo(y1.z), bfhi(y1.z), bflo(y1.w), bfhi(y1.w)} * rstd * g3;
}

__device__ __forceinline__ void p0_prologue(const Args& a, LAS unsigned char* lds, int tid, int lane, int wave) {
    unsigned char* ws = a.ws;
    bf16* Win_t = (bf16*)(ws + WS_WIN); bf16* Wout_t = (bf16*)(ws + WS_WOUT); bf16* Wup_t = (bf16*)(ws + WS_WUP); bf16* Wdn_t = (bf16*)(ws + WS_WDN);
    bf16* HN = (bf16*)(ws + WS_HN); bf16* P = (bf16*)(ws + WS_P);
    const int G = gridDim.x, gw = blockIdx.x * NWAVES + wave, NGW = G * NWAVES;
    LAS float* scr = (LAS float*)(lds + wave * 16384);
    constexpr int I_IN = 16 * (NIN / 32), I_OUT = 16 * (D / 32), I_UP = 16 * (FF / 32), I_DN = (FF / 64) * (D / 32);
    constexpr int NITEMS = I_IN + I_OUT + I_UP + I_DN;
    for (int it = gw; it < NITEMS; it += NGW) {
        int r = it;
        if (r < I_IN) { transpose_item<true>(a.w_in, D, NIN_SRC, Win_t, scr, r / (NIN / 32), r % (NIN / 32), lane); continue; } r -= I_IN;
        if (r < I_OUT) { transpose_item<false>(a.w_out, D, D, Wout_t, scr, r / (D / 32), r % (D / 32), lane); continue; } r -= I_OUT;
        if (r < I_UP) { transpose_item<false>(a.w_up, D, FF, Wup_t, scr, r / (FF / 32), r % (FF / 32), lane, a.norm2_g); continue; } r -= I_UP;
        transpose_item<false>(a.w_down, FF, D, Wdn_t, scr, r / (D / 32), r % (D / 32), lane);
    }
    for (int m = gw; m < MR; m += NGW) rms_row_to_bf16(a.x + (size_t)m * D, a.norm1_g, HN + (size_t)m * D, lane);
    { v4u z = {0u, 0u, 0u, 0u}; v4u* pz = (v4u*)(P + (size_t)MR * NIN);
      for (int i = blockIdx.x * NTHREADS + tid; i < NPAD * NIN / 8; i += G * NTHREADS) pz[i] = z; }
    __syncthreads();
    LAS float* hm = (LAS float*)lds;
#pragma unroll
    for (int rr = 0; rr < 2; ++rr) { const int r = wave * 2 + rr; const f32x4* xr = (const f32x4*)(a.meta + (size_t)r * D) + lane; f32x4 v[4]; float s = 0.f;
#pragma unroll
        for (int j = 0; j < 4; ++j) { v[j] = xr[64 * j]; s += (v[j].x * v[j].x + v[j].y * v[j].y) + (v[j].z * v[j].z + v[j].w * v[j].w); }
        const float rstd = rsqrtf(wave_sum(s) * (1.f / D) + EPS);
#pragma unroll
        for (int j = 0; j < 4; ++j) { const f32x4 gv = ((const f32x4*)a.norm1_g)[lane + 64 * j]; ((LAS f32x4*)(hm + r * D))[lane + 64 * j] = v[j] * rstd * gv; } }
    __syncthreads();
    for (int cb = blockIdx.x; cb * 15 < NIN; cb += G) {
        const int j = tid >> 5, ks = tid & 31; const int n = cb * 15 + j; const int src = (j < 15 && n < NIN) ? win_src(n) : -1;
        float acc[16];
#pragma unroll
        for (int r = 0; r < 16; ++r) acc[r] = 0.f;
        if (src >= 0) {
            for (int kk = 0; kk < 32; ++kk) { const int k = kk * 32 + ks; const float w = a.w_in[(size_t)k * NIN_SRC + src];
#pragma unroll
                for (int r = 0; r < 16; ++r) acc[r] += hm[r * D + k] * w; }
        }
#pragma unroll
        for (int r = 0; r < 16; ++r) { float v = acc[r]; v += __shfl_xor(v, 1); v += __shfl_xor(v, 2); v += __shfl_xor(v, 4); v += __shfl_xor(v, 8); v += __shfl_xor(v, 16); acc[r] = v; }
        float val = 0.f;
#pragma unroll
        for (int r = 0; r < 16; ++r) if (ks == r) val = acc[r];
        if (j < 15 && n < NIN && ks < 16) P[(size_t)(MR + NPAD + ks) * NIN + n] = (bf16)f2bf(val);
    }
    __syncthreads();
}

typedef short bf16x8 __attribute__((ext_vector_type(8)));
#define MFMA16(A_, B_, C_) __builtin_amdgcn_mfma_f32_16x16x32_bf16(A_, B_, C_, 0, 0, 0)
#define SB() __builtin_amdgcn_sched_barrier(0)
#define LBAR() do { asm volatile("s_waitcnt lgkmcnt(0)" ::: "memory"); __builtin_amdgcn_s_barrier(); asm volatile("" ::: "memory"); } while (0)
constexpr size_t WS_QH = 32 * MiB, WS_KH = 96 * MiB;
constexpr size_t WS_KT = 770 * MiB, WS_W = 836 * MiB, WS_UT = 902 * MiB, WS_GC = 968 * MiB, WS_GL = 970 * MiB;
constexpr size_t OUT_SN = 0, OUT_DS = 128 * MiB;
constexpr int LD72 = 72;

struct GlaRaw { v4u L0, L1; float w2[16]; float bias; };
__device__ __forceinline__ void gla_gates_load(const Args& a, const bf16* P, int b, int h, int n, int wave, int lane, GlaRaw& r) {
#pragma unroll
    for (int i = 0; i < 16; ++i) r.w2[i] = a.gla_w2[i * 256 + h * 64 + lane];
    r.bias = a.gla_b[h * 64 + lane];
    const bf16* pr = P + rowof(b, n * CH + wave * 8 + (lane & 7)) * NIN; r.L0 = *(const v4u*)(pr + C_LR); r.L1 = *(const v4u*)(pr + C_LR + 8);
}
__device__ __forceinline__ unsigned rdlane(unsigned v, int l) { return (unsigned)__builtin_amdgcn_readlane((int)v, l); }
__device__ __forceinline__ void gla_gates_compute(const GlaRaw& r, int n, int wave, int lane, LAS float* gs, float (&bc)[8], float& blast, float& bref) {
    float run = 0.f;
#pragma unroll
    for (int i = 0; i < 8; ++i) { const int t = n * CH + wave * 8 + i;
        v4u l0, l1; l0.x = rdlane(r.L0.x, i); l0.y = rdlane(r.L0.y, i); l0.z = rdlane(r.L0.z, i); l0.w = rdlane(r.L0.w, i); l1.x = rdlane(r.L1.x, i); l1.y = rdlane(r.L1.y, i); l1.z = rdlane(r.L1.z, i); l1.w = rdlane(r.L1.w, i);
        float x = r.bias;
        x += bflo(l0.x) * r.w2[0] + bfhi(l0.x) * r.w2[1] + bflo(l0.y) * r.w2[2] + bfhi(l0.y) * r.w2[3] + bflo(l0.z) * r.w2[4] + bfhi(l0.z) * r.w2[5] + bflo(l0.w) * r.w2[6] + bfhi(l0.w) * r.w2[7];
        x += bflo(l1.x) * r.w2[8] + bfhi(l1.x) * r.w2[9] + bflo(l1.y) * r.w2[10] + bfhi(l1.y) * r.w2[11] + bflo(l1.z) * r.w2[12] + bfhi(l1.z) * r.w2[13] + bflo(l1.w) * r.w2[14] + bfhi(l1.w) * r.w2[15];
        float g = logsigmoidf_(x) * (1.f / 16.f); if (t < NPAD) g = 0.f;
        run += g; bc[i] = run; }
    gs[wave * 64 + lane] = run; gs[512 + wave * 64 + lane] = bc[0];
    LBAR();
    float tv[8];
#pragma unroll
    for (int w = 0; w < 8; ++w) tv[w] = gs[w * 64 + lane];
    const float f4 = gs[512 + 4 * 64 + lane];
    float off = 0.f, tot = 0.f, br = 0.f;
#pragma unroll
    for (int w = 0; w < 8; ++w) { if (w < wave) off += tv[w]; if (w < 4) br += tv[w]; tot += tv[w]; }
    br += f4;
#pragma unroll
    for (int i = 0; i < 8; ++i) bc[i] += off;
    blast = tot; bref = br;
}
__device__ __forceinline__ void load_v_raw(const bf16* P, int b, int n, int vcol0, int tid, unsigned short (&vr)[16]) {
    const int e = tid & 127, cg4 = tid >> 7;
#pragma unroll
    for (int i = 0; i < 16; ++i) vr[i] = P[rowof(b, n * CH + cg4 * 16 + i) * NIN + vcol0 + e];
}
__device__ __forceinline__ void store_vT(const unsigned short (&vr)[16], LAS bf16* vT, int tid) {
    const int e = tid & 127, cg4 = tid >> 7; unsigned pk[8];
#pragma unroll
    for (int i = 0; i < 8; ++i) pk[i] = (unsigned)vr[2 * i] | ((unsigned)vr[2 * i + 1] << 16);
    LAS v4u* dst = (LAS v4u*)(vT + e * LD72 + cg4 * 16);
    dst[0] = (v4u){pk[0], pk[1], pk[2], pk[3]}; dst[1] = (v4u){pk[4], pk[5], pk[6], pk[7]};
}
constexpr int GL_VT = 0, GL_KDT = 18432, GL_QI = 18432, GL_KI = 27648, GL_QG = 36864, GL_AB = 46080, GL_GS = 55296, GL_SS = 59392;

__device__ __forceinline__ void gla_p2_item(const Args& a, int item, LAS unsigned char* lds, int tid, int lane, int wave) {
    const int n = item & 63, h = (item >> 6) & 3, b = item >> 8;
    const bf16* P = (const bf16*)(a.ws + WS_P);
    float* DS = (float*)((unsigned char*)a.out + OUT_DS) + (size_t)item * 8192; float* GL = (float*)(a.ws + WS_GL) + (size_t)item * 64;
    LAS bf16* vT = (LAS bf16*)(lds + GL_VT); LAS bf16* kdT = (LAS bf16*)(lds + GL_KDT); LAS float* gs = (LAS float*)(lds + GL_GS);
    GlaRaw gr; unsigned short kr[8], vr[16];
    gla_gates_load(a, P, b, h, n, wave, lane, gr);
#pragma unroll
    for (int i = 0; i < 8; ++i) kr[i] = P[rowof(b, n * CH + wave * 8 + i) * NIN + C_GK + h * 64 + lane];
    load_v_raw(P, b, n, C_GV + h * 128, tid, vr);
    SB();
    float bc[8], blast, bref;
    gla_gates_compute(gr, n, wave, lane, gs, bc, blast, bref);
    { unsigned pk[4];
#pragma unroll
      for (int i = 0; i < 4; ++i) pk[i] = pk2(bf2f(kr[2 * i]) * __expf(blast - bc[2 * i]), bf2f(kr[2 * i + 1]) * __expf(blast - bc[2 * i + 1]));
      *(LAS v4u*)(kdT + lane * LD72 + wave * 8) = (v4u){pk[0], pk[1], pk[2], pk[3]}; }
    store_vT(vr, vT, tid);
    if (wave == 0) GL[lane] = __expf(blast);
    LBAR();
    const int fr = lane & 15, fq = lane >> 4;
    bf16x8 X[2];
#pragma unroll
    for (int ks = 0; ks < 2; ++ks) X[ks] = *(const LAS bf16x8*)(vT + (16 * wave + fr) * LD72 + 32 * ks + 8 * fq);
#pragma unroll
    for (int nt = 0; nt < 4; ++nt) { f32x4 acc = {0.f, 0.f, 0.f, 0.f};
#pragma unroll
        for (int ks = 0; ks < 2; ++ks) { const bf16x8 Y = *(const LAS bf16x8*)(kdT + (16 * nt + fr) * LD72 + 32 * ks + 8 * fq); acc = MFMA16(Y, X[ks], acc); }
        *(f32x4*)(DS + (16 * wave + fr) * 64 + 16 * nt + 4 * fq) = acc; }
    LBAR();
}
__device__ __forceinline__ void gla_p3_scan(const Args& a, int tid) {
    const int G = gridDim.x;
    for (int gid = blockIdx.x * NTHREADS + tid; gid < 64 * 2048; gid += G * NTHREADS) {
        const int bh = gid >> 11, within = gid & 2047, e = within >> 4, d4 = (within & 15) * 4;
        float* DS = (float*)((unsigned char*)a.out + OUT_DS) + (size_t)bh * 64 * 8192 + e * 64 + d4; const float* GL = (const float*)(a.ws + WS_GL) + (size_t)bh * 64 * 64 + d4;
        f32x4 S = {0.f, 0.f, 0.f, 0.f};
        for (int n0 = 0; n0 < 64; n0 += 8) { f32x4 ds[8], gl[8];
#pragma unroll
            for (int j = 0; j < 8; ++j) { ds[j] = *(const f32x4*)(DS + (size_t)(n0 + j) * 8192); gl[j] = *(const f32x4*)(GL + (n0 + j) * 64); }
            SB();
#pragma unroll
            for (int j = 0; j < 8; ++j) { S = gl[j] * S + ds[j]; *(f32x4*)(DS + (size_t)(n0 + j) * 8192) = S; } }
    }
}
__device__ __forceinline__ void gla_p4_item(const Args& a, int item, LAS unsigned char* lds, int tid, int lane, int wave) {
    const int n = (item & 63) + 1, h = (item >> 6) & 3, b = item >> 8;
    const bf16* P = (const bf16*)(a.ws + WS_P); bf16* MIX = (bf16*)(a.ws + WS_MIX);
    const float* SN = (const float*)((const unsigned char*)a.out + OUT_DS) + (size_t)item * 8192;
    LAS bf16* vT = (LAS bf16*)(lds + GL_VT); LAS bf16* QI = (LAS bf16*)(lds + GL_QI); LAS bf16* KI = (LAS bf16*)(lds + GL_KI); LAS bf16* QG = (LAS bf16*)(lds + GL_QG); LAS bf16* Ab = (LAS bf16*)(lds + GL_AB);
    LAS float* gs = (LAS float*)(lds + GL_GS); LAS float* ss = (LAS float*)(lds + GL_SS);
    const size_t row0 = (size_t)b * SEQ + (size_t)(n - 1) * CH;
    const int fr = lane & 15, fq = lane >> 4;
    GlaRaw gr; unsigned short qr[8], kr[8], vr[16];
    gla_gates_load(a, P, b, h, n, wave, lane, gr);
#pragma unroll
    for (int i = 0; i < 8; ++i) { const bf16* pr = P + (row0 + wave * 8 + i) * NIN; qr[i] = pr[C_GQ + h * 64 + lane]; kr[i] = pr[C_GK + h * 64 + lane]; }
    load_v_raw(P, b, n, C_GV + h * 128, tid, vr);
    SB();
    float bc[8], blast, bref;
    gla_gates_compute(gr, n, wave, lane, gs, bc, blast, bref);
    const int mt = wave & 3, c = 16 * mt + fr;
    f32x4 sn[4][2][2]; v2u rz[4]; f32x4 gv[4];
#pragma unroll
    for (int i = 0; i < 4; ++i) { const int nt = 4 * (wave >> 2) + i;
#pragma unroll
        for (int ks = 0; ks < 2; ++ks) { const float* sp = SN + (16 * nt + fr) * 64 + 32 * ks + 8 * fq; sn[i][ks][0] = *(const f32x4*)sp; sn[i][ks][1] = *(const f32x4*)(sp + 4); }
        const int e0 = 16 * nt + 4 * fq; rz[i] = *(const v2u*)(P + (row0 + c) * NIN + C_GR + h * 128 + e0); gv[i] = *(const f32x4*)(a.gla_norm_g + e0); }
    SB();
#pragma unroll
    for (int i = 0; i < 8; ++i) { const int cc = wave * 8 + i; const float q = bf2f(qr[i]) * 0.125f, k = bf2f(kr[i]);
        QI[cc * LD72 + lane] = (bf16)f2bf(q * __expf(bc[i] - bref)); KI[cc * LD72 + lane] = (bf16)f2bf(k * __expf(bref - bc[i])); QG[cc * LD72 + lane] = (bf16)f2bf(q * __expf(bc[i])); }
    store_vT(vr, vT, tid);
    LBAR();
    { const int mta = wave >> 1; bf16x8 X[2], Y[2][2];
#pragma unroll
      for (int ks = 0; ks < 2; ++ks) { X[ks] = *(const LAS bf16x8*)(QI + (16 * mta + fr) * LD72 + 32 * ks + 8 * fq);
#pragma unroll
          for (int j2 = 0; j2 < 2; ++j2) Y[j2][ks] = *(const LAS bf16x8*)(KI + (16 * (2 * (wave & 1) + j2) + fr) * LD72 + 32 * ks + 8 * fq); }
#pragma unroll
      for (int j2 = 0; j2 < 2; ++j2) { const int nt = 2 * (wave & 1) + j2; f32x4 acc = {0.f, 0.f, 0.f, 0.f};
#pragma unroll
          for (int ks = 0; ks < 2; ++ks) acc = MFMA16(Y[j2][ks], X[ks], acc);
          const int ca = 16 * mta + fr, s0 = 16 * nt + 4 * fq;
#pragma unroll
          for (int j = 0; j < 4; ++j) if (s0 + j > ca) acc[j] = 0.f;
          *(LAS v2u*)(Ab + ca * LD72 + s0) = (v2u){pk2(acc[0], acc[1]), pk2(acc[2], acc[3])}; } }
    LBAR();
    f32x4 o[4];
    { bf16x8 XA[2], XQ[2], YV[4][2];
#pragma unroll
      for (int ks = 0; ks < 2; ++ks) { XA[ks] = *(const LAS bf16x8*)(Ab + c * LD72 + 32 * ks + 8 * fq); XQ[ks] = *(const LAS bf16x8*)(QG + c * LD72 + 32 * ks + 8 * fq);
#pragma unroll
          for (int i = 0; i < 4; ++i) YV[i][ks] = *(const LAS bf16x8*)(vT + (16 * (4 * (wave >> 2) + i) + fr) * LD72 + 32 * ks + 8 * fq); }
#pragma unroll
      for (int i = 0; i < 4; ++i) { f32x4 acc = {0.f, 0.f, 0.f, 0.f};
#pragma unroll
          for (int ks = 0; ks < 2; ++ks) acc = MFMA16(YV[i][ks], XA[ks], acc);
#pragma unroll
          for (int ks = 0; ks < 2; ++ks) { const f32x4 s0 = sn[i][ks][0], s1 = sn[i][ks][1];
              const v4u yp = {pk2(s0[0], s0[1]), pk2(s0[2], s0[3]), pk2(s1[0], s1[1]), pk2(s1[2], s1[3])}; acc = MFMA16(__builtin_bit_cast(bf16x8, yp), XQ[ks], acc); }
          o[i] = acc; } }
    float sq = 0.f;
#pragma unroll
    for (int i = 0; i < 4; ++i) sq += (o[i][0] * o[i][0] + o[i][1] * o[i][1]) + (o[i][2] * o[i][2] + o[i][3] * o[i][3]);
    sq += __shfl_xor(sq, 16); sq += __shfl_xor(sq, 32);
    if (fq == 0) ss[(wave >> 2) * 64 + c] = sq;
    LBAR();
    const float rstd = rsqrtf((ss[c] + ss[64 + c]) * (1.f / 128.f) + EPS);
#pragma unroll
    for (int i = 0; i < 4; ++i) { const int e0 = 16 * (4 * (wave >> 2) + i) + 4 * fq;
        const float r0 = o[i][0] * rstd * gv[i][0] * siluf_(bflo(rz[i].x)), r1 = o[i][1] * rstd * gv[i][1] * siluf_(bfhi(rz[i].x)), r2 = o[i][2] * rstd * gv[i][2] * siluf_(bflo(rz[i].y)), r3 = o[i][3] * rstd * gv[i][3] * siluf_(bfhi(rz[i].y));
        *(v2u*)(MIX + (row0 + c) * D + 512 + h * 128 + e0) = (v2u){pk2(r0, r1), pk2(r2, r3)}; }
    LBAR();
}

typedef float f32x2 __attribute__((ext_vector_type(2)));
constexpr int LD136 = 136;
constexpr int LDF = 68;
constexpr int DN_KL = 0, DN_VL = 17408, DN_KBGT = 34816, DN_VBT = 53248, DN_AF = 71680, DN_TF = 89088, DN_TB = 106496, DN_XS = 115712, DN_YS = 117760, DN_GC = 122880, DN_BETA = 123136;
constexpr float QSCALE = 0.08838834764831845f;

__device__ __forceinline__ void dn_p2_item(const Args& a, int item, LAS unsigned char* lds, int tid, int lane, int wave) {
    const int n = item % 65, bh = item / 65, h = bh & 3, b = bh >> 2;
    const int itemq = bh * 64 + n - 1;
    const bf16* P = (const bf16*)(a.ws + WS_P);
    bf16* QH = (bf16*)(a.ws + WS_QH) + (size_t)itemq * 8192; bf16* KH = (bf16*)(a.ws + WS_KH) + (size_t)itemq * 8192;
    bf16* KT = (bf16*)(a.ws + WS_KT) + (size_t)item * 8192; bf16* Wg = (bf16*)(a.ws + WS_W) + (size_t)item * 8192; bf16* UT = (bf16*)(a.ws + WS_UT) + (size_t)item * 8192;
    float* GC = (float*)(a.ws + WS_GC) + (size_t)item * 64;
    LAS bf16* Kl = (LAS bf16*)(lds + DN_KL); LAS bf16* Vl = (LAS bf16*)(lds + DN_VL); LAS bf16* KBGt = (LAS bf16*)(lds + DN_KBGT); LAS bf16* VBt = (LAS bf16*)(lds + DN_VBT);
    LAS float* Af = (LAS float*)(lds + DN_AF); LAS float* Tf = (LAS float*)(lds + DN_TF); LAS bf16* Tb = (LAS bf16*)(lds + DN_TB);
    LAS float* Xs = (LAS float*)(lds + DN_XS); LAS float* Ys = (LAS float*)(lds + DN_YS); LAS float* gcl = (LAS float*)(lds + DN_GC); LAS float* betal = (LAS float*)(lds + DN_BETA);
    const int fr = lane & 15, fq = lane >> 4;
    { const int j = tid & 15, rg = tid >> 4;
      v4u raw[3][5]; unsigned short gb = 0, ga = 0;
#pragma unroll
      for (int rr = 0; rr < 5; ++rr) { const int t = n * CH + 2 * rg - 3 + rr; const bf16* pr = P + rowof(b, t < 0 ? 0 : t) * NIN + h * 128 + 8 * j;
#pragma unroll
          for (int arr = 0; arr < 3; ++arr) { raw[arr][rr] = *(const v4u*)(pr + arr * 512); if (t < 0) raw[arr][rr] = (v4u){0u, 0u, 0u, 0u}; } }
      if (wave == 0) { const bf16* pr = P + rowof(b, n * CH + lane) * NIN; gb = pr[C_BETA + h]; ga = pr[C_A + h]; }
      SB();
#pragma unroll
      for (int arr = 0; arr < 3; ++arr) {
          const int col = arr * 512 + h * 128 + 8 * j;
          f32x4 w0[4], w1[4];
#pragma unroll
          for (int i = 0; i < 4; ++i) { w0[i] = *(const f32x4*)(a.conv_w + i * 1536 + col); w1[i] = *(const f32x4*)(a.conv_w + i * 1536 + col + 4); }
          SB();
          float x[5][8];
#pragma unroll
          for (int rr = 0; rr < 5; ++rr) { const v4u r4 = raw[arr][rr];
              x[rr][0] = bflo(r4.x); x[rr][1] = bfhi(r4.x); x[rr][2] = bflo(r4.y); x[rr][3] = bfhi(r4.y); x[rr][4] = bflo(r4.z); x[rr][5] = bfhi(r4.z); x[rr][6] = bflo(r4.w); x[rr][7] = bfhi(r4.w); }
          float y[2][8];
#pragma unroll
          for (int r = 0; r < 2; ++r)
#pragma unroll
              for (int c8 = 0; c8 < 8; ++c8) y[r][c8] = 0.f;
#pragma unroll
          for (int i = 0; i < 4; ++i) {
#pragma unroll
              for (int r = 0; r < 2; ++r) { y[r][0] += w0[i][0] * x[r + i][0]; y[r][1] += w0[i][1] * x[r + i][1]; y[r][2] += w0[i][2] * x[r + i][2]; y[r][3] += w0[i][3] * x[r + i][3];
                  y[r][4] += w1[i][0] * x[r + i][4]; y[r][5] += w1[i][1] * x[r + i][5]; y[r][6] += w1[i][2] * x[r + i][6]; y[r][7] += w1[i][3] * x[r + i][7]; } }
#pragma unroll
          for (int r = 0; r < 2; ++r) { const int c = 2 * rg + r;
#pragma unroll
              for (int c8 = 0; c8 < 8; ++c8) y[r][c8] = siluf_(y[r][c8]);
              if (arr < 2) { float sq = 0.f;
#pragma unroll
                  for (int c8 = 0; c8 < 8; ++c8) sq += y[r][c8] * y[r][c8];
                  sq += __shfl_xor(sq, 1); sq += __shfl_xor(sq, 2); sq += __shfl_xor(sq, 4); sq += __shfl_xor(sq, 8);
                  const float rs = rsqrtf(sq + EPS) * (arr == 0 ? QSCALE : 1.f);
#pragma unroll
                  for (int c8 = 0; c8 < 8; ++c8) y[r][c8] *= rs; }
              const v4u pk = {pk2(y[r][0], y[r][1]), pk2(y[r][2], y[r][3]), pk2(y[r][4], y[r][5]), pk2(y[r][6], y[r][7])};
              if (arr == 0) { if (n >= 1) *(v4u*)(QH + c * 128 + 8 * j) = pk; }
              else if (arr == 1) { *(LAS v4u*)(Kl + c * LD136 + 8 * j) = pk; if (n >= 1) *(v4u*)(KH + c * 128 + 8 * j) = pk; }
              else { *(LAS v4u*)(Vl + c * LD136 + 8 * j) = pk; } } }
      if (wave == 0) { const int t = n * CH + lane;
          const float beta = sigmoidf_(bf2f(gb)); float g = -__expf(a.a_log[h]) * softplusf_(bf2f(ga) + a.dt_bias[h]); if (t < NPAD) g = 0.f;
#pragma unroll
          for (int o = 1; o < 64; o <<= 1) { const float up = __shfl_up(g, o); if (lane >= o) g += up; }
          gcl[lane] = g; betal[lane] = beta; GC[lane] = g; } }
    for (int i = tid; i < 64 * LDF; i += NTHREADS) Tf[i] = 0.f;
    LBAR();
    { const int mt = wave >> 1; bf16x8 X[4], Y[2][4];
#pragma unroll
      for (int ks = 0; ks < 4; ++ks) { X[ks] = *(const LAS bf16x8*)(Kl + (16 * mt + fr) * LD136 + 32 * ks + 8 * fq);
#pragma unroll
          for (int j2 = 0; j2 < 2; ++j2) Y[j2][ks] = *(const LAS bf16x8*)(Kl + (16 * (2 * (wave & 1) + j2) + fr) * LD136 + 32 * ks + 8 * fq); }
      const int c = 16 * mt + fr; const float bc = betal[c], gcc = gcl[c];
#pragma unroll
      for (int j2 = 0; j2 < 2; ++j2) { const int nt = 2 * (wave & 1) + j2; f32x4 acc = {0.f, 0.f, 0.f, 0.f};
#pragma unroll
          for (int ks = 0; ks < 4; ++ks) acc = MFMA16(Y[j2][ks], X[ks], acc);
          const int s0 = 16 * nt + 4 * fq; const f32x4 gsv = *(const LAS f32x4*)(gcl + s0);
#pragma unroll
          for (int jj = 0; jj < 4; ++jj) { const float ev = __expf(fminf(gcc - gsv[jj], 0.f)); acc[jj] = (s0 + jj < c) ? acc[jj] * bc * ev : 0.f; }
          *(LAS f32x4*)(Af + c * LDF + s0) = acc; } }
    { const int d = tid & 127, cg4 = tid >> 7; unsigned short kk[16], vv[16]; float bb[16], ee[16];
#pragma unroll
      for (int i = 0; i < 16; ++i) { const int s = 16 * cg4 + i; kk[i] = Kl[s * LD136 + d]; vv[i] = Vl[s * LD136 + d]; }
#pragma unroll
      for (int i4 = 0; i4 < 4; ++i4) { const f32x4 b4 = *(const LAS f32x4*)(betal + 16 * cg4 + 4 * i4), g4 = *(const LAS f32x4*)(gcl + 16 * cg4 + 4 * i4);
#pragma unroll
          for (int jj = 0; jj < 4; ++jj) { bb[4 * i4 + jj] = b4[jj]; ee[4 * i4 + jj] = __expf(g4[jj]); } }
      unsigned pkk[8], pkb[8], pkv[8];
#pragma unroll
      for (int i = 0; i < 8; ++i) { pkk[i] = (unsigned)kk[2 * i] | ((unsigned)kk[2 * i + 1] << 16);
          pkb[i] = pk2(bf2f(kk[2 * i]) * bb[2 * i] * ee[2 * i], bf2f(kk[2 * i + 1]) * bb[2 * i + 1] * ee[2 * i + 1]); pkv[i] = pk2(bf2f(vv[2 * i]) * bb[2 * i], bf2f(vv[2 * i + 1]) * bb[2 * i + 1]); }
      *(LAS v4u*)(KBGt + d * LD72 + 16 * cg4) = (v4u){pkb[0], pkb[1], pkb[2], pkb[3]}; *(LAS v4u*)(KBGt + d * LD72 + 16 * cg4 + 8) = (v4u){pkb[4], pkb[5], pkb[6], pkb[7]};
      *(LAS v4u*)(VBt + d * LD72 + 16 * cg4) = (v4u){pkv[0], pkv[1], pkv[2], pkv[3]}; *(LAS v4u*)(VBt + d * LD72 + 16 * cg4 + 8) = (v4u){pkv[4], pkv[5], pkv[6], pkv[7]};
      *(v4u*)(KT + d * 64 + 16 * cg4) = (v4u){pkk[0], pkk[1], pkk[2], pkk[3]}; *(v4u*)(KT + d * 64 + 16 * cg4 + 8) = (v4u){pkk[4], pkk[5], pkk[6], pkk[7]}; }
    LBAR();
    if (tid < 64) { const int i = tid >> 4, col = tid & 15; float x[16]; f32x4 ar[16][4];
#pragma unroll
        for (int r = 1; r < 16; ++r)
#pragma unroll
            for (int j4 = 0; j4 < 4; ++j4) if (4 * j4 < r) ar[r][j4] = *(const LAS f32x4*)(Af + (16 * i + r) * LDF + 16 * i + 4 * j4);
#pragma unroll
        for (int r = 0; r < 16; ++r) { float s = (r == col) ? 1.f : 0.f;
#pragma unroll
            for (int j4 = 0; j4 < 4; ++j4) { if (4 * j4 < r) {
#pragma unroll
                for (int jj = 0; jj < 4; ++jj) if (4 * j4 + jj < r) s -= ar[r][j4][jj] * x[4 * j4 + jj]; } }
            x[r] = s; Tf[(16 * i + r) * LDF + 16 * i + col] = s; } }
    LBAR();
    { const int p = tid >> 8, r = (tid >> 4) & 15, cc = tid & 15, lo = 32 * p; f32x4 av[4]; float tv[16];
#pragma unroll
      for (int j4 = 0; j4 < 4; ++j4) av[j4] = *(const LAS f32x4*)(Af + (lo + 16 + r) * LDF + lo + 4 * j4);
#pragma unroll
      for (int j = 0; j < 16; ++j) tv[j] = Tf[(lo + j) * LDF + lo + cc];
      float s = 0.f;
#pragma unroll
      for (int j = 0; j < 16; ++j) s += av[j >> 2][j & 3] * tv[j];
      Xs[p * 256 + r * 16 + cc] = s;
      LBAR();
#pragma unroll
      for (int j4 = 0; j4 < 4; ++j4) av[j4] = *(const LAS f32x4*)(Tf + (lo + 16 + r) * LDF + lo + 16 + 4 * j4);
#pragma unroll
      for (int j = 0; j < 16; ++j) tv[j] = Xs[p * 256 + j * 16 + cc];
      float s2 = 0.f;
#pragma unroll
      for (int j = 0; j < 16; ++j) s2 += av[j >> 2][j & 3] * tv[j];
      Tf[(lo + 16 + r) * LDF + lo + cc] = -s2; }
    LBAR();
    { const int r = tid >> 4, c2 = (tid & 15) * 2; f32x4 av[8]; f32x2 tv[32];
#pragma unroll
      for (int j4 = 0; j4 < 8; ++j4) av[j4] = *(const LAS f32x4*)(Af + (32 + r) * LDF + 4 * j4);
#pragma unroll
      for (int j = 0; j < 32; ++j) tv[j] = *(const LAS f32x2*)(Tf + j * LDF + c2);
      float s0 = 0.f, s1 = 0.f;
#pragma unroll
      for (int j = 0; j < 32; ++j) { s0 += av[j >> 2][j & 3] * tv[j][0]; s1 += av[j >> 2][j & 3] * tv[j][1]; }
      Ys[r * 33 + c2] = s0; Ys[r * 33 + c2 + 1] = s1;
      LBAR();
#pragma unroll
      for (int j4 = 0; j4 < 8; ++j4) av[j4] = *(const LAS f32x4*)(Tf + (32 + r) * LDF + 32 + 4 * j4);
      float y0[32], y1[32];
#pragma unroll
      for (int j = 0; j < 32; ++j) { y0[j] = Ys[j * 33 + c2]; y1[j] = Ys[j * 33 + c2 + 1]; }
      float t0 = 0.f, t1 = 0.f;
#pragma unroll
      for (int j = 0; j < 32; ++j) { t0 += av[j >> 2][j & 3] * y0[j]; t1 += av[j >> 2][j & 3] * y1[j]; }
      Tf[(32 + r) * LDF + c2] = -t0; Tf[(32 + r) * LDF + c2 + 1] = -t1; }
    LBAR();
    { const int c = tid >> 3, s8 = (tid & 7) * 8; const f32x4 t0 = *(const LAS f32x4*)(Tf + c * LDF + s8), t1 = *(const LAS f32x4*)(Tf + c * LDF + s8 + 4);
      *(LAS v4u*)(Tb + c * LD72 + s8) = (v4u){pk2(t0[0], t0[1]), pk2(t0[2], t0[3]), pk2(t1[0], t1[1]), pk2(t1[2], t1[3])}; }
    LBAR();
    { const int mt = wave & 3; bf16x8 X[2], Y[4][2], XV[2], YT[4][2];
#pragma unroll
      for (int ks = 0; ks < 2; ++ks) { X[ks] = *(const LAS bf16x8*)(Tb + (16 * mt + fr) * LD72 + 32 * ks + 8 * fq); XV[ks] = *(const LAS bf16x8*)(VBt + (16 * wave + fr) * LD72 + 32 * ks + 8 * fq);
#pragma unroll
          for (int i = 0; i < 4; ++i) { Y[i][ks] = *(const LAS bf16x8*)(KBGt + (16 * (4 * (wave >> 2) + i) + fr) * LD72 + 32 * ks + 8 * fq); YT[i][ks] = *(const LAS bf16x8*)(Tb + (16 * i + fr) * LD72 + 32 * ks + 8 * fq); } }
#pragma unroll
      for (int i = 0; i < 4; ++i) { const int nt = 4 * (wave >> 2) + i; f32x4 acc = {0.f, 0.f, 0.f, 0.f};
#pragma unroll
          for (int ks = 0; ks < 2; ++ks) acc = MFMA16(Y[i][ks], X[ks], acc);
          *(v2u*)(Wg + (16 * mt + fr) * 128 + 16 * nt + 4 * fq) = (v2u){pk2(acc[0], acc[1]), pk2(acc[2], acc[3])}; }
#pragma unroll
      for (int nt = 0; nt < 4; ++nt) { f32x4 acc = {0.f, 0.f, 0.f, 0.f};
#pragma unroll
          for (int ks = 0; ks < 2; ++ks) acc = MFMA16(YT[nt][ks], XV[ks], acc);
          *(v2u*)(UT + (16 * wave + fr) * 64 + 16 * nt + 4 * fq) = (v2u){pk2(acc[0], acc[1]), pk2(acc[2], acc[3])}; } }
    LBAR();
}

struct P3Regs { bf16x8 wf[4], ktf[2]; v2u ut; f32x4 gcv; float gclast; f32x4 gds, ggl; };
struct P3Ptrs { const bf16* Wb; bf16* UTb; const bf16* KTb; const float* GCb; const float* GCl; bf16* dummy; bf16* SNb; float* DSg; const float* GLg; int ct, fq; bool gla; };
template <bool GLA> __device__ __forceinline__ void p3_load(P3Regs& r, const P3Ptrs& p, int n) {
    const int nn = n < 65 ? n : 64, ng = n < 64 ? n : 63; const size_t o = (size_t)nn * 8192;
#pragma unroll
    for (int ks = 0; ks < 4; ++ks) r.wf[ks] = *(const bf16x8*)(p.Wb + o + 32 * ks);
#pragma unroll
    for (int ks = 0; ks < 2; ++ks) r.ktf[ks] = *(const bf16x8*)(p.KTb + o + 32 * ks);
    r.ut = *(const v2u*)(p.UTb + o); r.gcv = *(const f32x4*)(p.GCb + nn * 64 + 16 * p.ct + 4 * p.fq); r.gclast = p.GCl[nn * 64];
    if (GLA) { r.gds = *(const f32x4*)(p.DSg + (size_t)ng * 8192); r.ggl = *(const f32x4*)(p.GLg + ng * 64); }
}
template <bool GLA, bool DRY> __device__ __forceinline__ void p3_step(const P3Regs& r, const P3Ptrs& p, int n, f32x4 (&acc)[2], f32x4& Sg, LAS bf16* Sb, LAS bf16* Vt, int fr, int fq, int wave) {
    const int et1 = wave & 1, ct = wave >> 1;
    if (GLA) { Sg = r.ggl * Sg + r.gds; if (!DRY) *(f32x4*)(p.DSg + (size_t)n * 8192) = Sg; }
#pragma unroll
    for (int et = 0; et < 2; ++et) { const v2u sp = {pk2(acc[et][0], acc[et][1]), pk2(acc[et][2], acc[et][3])};
        *(LAS v2u*)(Sb + (16 * et + fr) * LD136 + 16 * wave + 4 * fq) = sp;
        v2u* dst = (n >= 1) ? (v2u*)(p.SNb + (size_t)(n - 1) * 16384 + et * 16 * 128) : (v2u*)(p.dummy + 4 * et); *dst = sp; }
    LBAR();
    { f32x4 av = {0.f, 0.f, 0.f, 0.f};
      const LAS bf16* xp = Sb + (16 * et1 + fr) * LD136 + 8 * fq;
      const bf16x8 x0 = *(const LAS bf16x8*)(xp), x1 = *(const LAS bf16x8*)(xp + 32), x2 = *(const LAS bf16x8*)(xp + 64), x3 = *(const LAS bf16x8*)(xp + 96);
      av = MFMA16(r.wf[0], x0, av); av = MFMA16(r.wf[1], x1, av); av = MFMA16(r.wf[2], x2, av); av = MFMA16(r.wf[3], x3, av);
      const float v0 = bflo(r.ut.x) - av[0], v1 = bfhi(r.ut.x) - av[1], v2 = bflo(r.ut.y) - av[2], v3 = bfhi(r.ut.y) - av[3];
      if (!DRY) *(v2u*)(p.UTb + (size_t)n * 8192) = (v2u){pk2(v0, v1), pk2(v2, v3)};
      *(LAS v2u*)(Vt + (16 * et1 + fr) * LD72 + 16 * ct + 4 * fq) = (v2u){pk2(v0 * __expf(r.gclast - r.gcv[0]), v1 * __expf(r.gclast - r.gcv[1])), pk2(v2 * __expf(r.gclast - r.gcv[2]), v3 * __expf(r.gclast - r.gcv[3]))}; }
    LBAR();
    { const float gl = __expf(r.gclast);
      const LAS bf16* xp0 = Vt + fr * LD72 + 8 * fq; const LAS bf16* xp1 = Vt + (16 + fr) * LD72 + 8 * fq;
      const bf16x8 a0 = *(const LAS bf16x8*)(xp0), a1 = *(const LAS bf16x8*)(xp0 + 32), b0 = *(const LAS bf16x8*)(xp1), b1 = *(const LAS bf16x8*)(xp1 + 32);
      acc[0] = acc[0] * gl; acc[1] = acc[1] * gl;
      acc[0] = MFMA16(r.ktf[0], a0, acc[0]); acc[1] = MFMA16(r.ktf[0], b0, acc[1]); acc[0] = MFMA16(r.ktf[1], a1, acc[0]); acc[1] = MFMA16(r.ktf[1], b1, acc[1]); }
}
template <bool GLA, bool DRY> __device__ __forceinline__ void dn_p3_unit(const Args& a, int unit, LAS unsigned char* lds, int tid, int lane, int wave) {
    const int sl = unit & 3, bh = unit >> 2;
    LAS bf16* Sb = (LAS bf16*)lds; LAS bf16* Vt = (LAS bf16*)(lds + 8704);
    const int fr = lane & 15, fq = lane >> 4, et1 = wave & 1, ct = wave >> 1;
    f32x4 acc[2] = {{0.f, 0.f, 0.f, 0.f}, {0.f, 0.f, 0.f, 0.f}}; f32x4 Sg = {0.f, 0.f, 0.f, 0.f};
    P3Ptrs p;
    p.Wb = (const bf16*)(a.ws + WS_W) + (size_t)bh * 65 * 8192 + (16 * ct + fr) * 128 + 8 * fq;
    p.UTb = (bf16*)(a.ws + WS_UT) + (size_t)bh * 65 * 8192 + (32 * sl + 16 * et1 + fr) * 64 + 16 * ct + 4 * fq;
    p.KTb = (const bf16*)(a.ws + WS_KT) + (size_t)bh * 65 * 8192 + (16 * wave + fr) * 64 + 8 * fq;
    p.GCb = (const float*)(a.ws + WS_GC) + (size_t)bh * 65 * 64;
    { int z = lane; asm volatile("" : "+v"(z)); p.GCl = p.GCb + 63 + (z & 64); }
    p.SNb = (bf16*)a.out + (size_t)bh * 64 * 16384 + (32 * sl + fr) * 128 + 16 * wave + 4 * fq;
    { const int gid = blockIdx.x * NTHREADS + tid, gbh = gid >> 11, within = gid & 2047, e = within >> 4, d4 = (within & 15) * 4;
      p.DSg = (float*)((unsigned char*)a.out + OUT_DS) + (size_t)gbh * 64 * 8192 + e * 64 + d4; p.GLg = (const float*)(a.ws + WS_GL) + (size_t)gbh * 64 * 64 + d4; }
    p.ct = ct; p.fq = fq; p.gla = GLA; p.dummy = (bf16*)(a.ws + 972 * MiB) + (size_t)(blockIdx.x * NTHREADS + tid) * 8;
    P3Regs R0, R1, R2;
    for (int n = 0; n < 63; n += 3) {
        p3_load<GLA>(R0, p, n); p3_load<GLA>(R1, p, n + 1); p3_load<GLA>(R2, p, n + 2);
        SB();
        p3_step<GLA, DRY>(R0, p, n, acc, Sg, Sb, Vt, fr, fq, wave);
        p3_step<GLA, DRY>(R1, p, n + 1, acc, Sg, Sb, Vt, fr, fq, wave);
        p3_step<GLA, DRY>(R2, p, n + 2, acc, Sg, Sb, Vt, fr, fq, wave);
        SB();
    }
    p3_load<GLA>(R0, p, 63); p3_load<false>(R1, p, 64);
    SB();
    p3_step<GLA, DRY>(R0, p, 63, acc, Sg, Sb, Vt, fr, fq, wave);
    p3_step<false, DRY>(R1, p, 64, acc, Sg, Sb, Vt, fr, fq, wave);
    LBAR();
}

__device__ __forceinline__ void dn_p4_wave(const Args& a, int itemq, LAS unsigned char* wl, int lane) {
    const int n = (itemq & 63) + 1, bh = itemq >> 6, h = bh & 3, b = bh >> 2; const int item = bh * 65 + n;
    const bf16* P = (const bf16*)(a.ws + WS_P); bf16* MIX = (bf16*)(a.ws + WS_MIX);
    const bf16* QH = (const bf16*)(a.ws + WS_QH) + (size_t)itemq * 8192; const bf16* KH = (const bf16*)(a.ws + WS_KH) + (size_t)itemq * 8192;
    const bf16* VN = (const bf16*)(a.ws + WS_UT) + (size_t)item * 8192; const bf16* SN = (const bf16*)a.out + (size_t)itemq * 16384;
    const float* GC = (const float*)(a.ws + WS_GC) + (size_t)item * 64;
    LAS bf16* Ab = (LAS bf16*)wl; LAS float* gcl = (LAS float*)(wl + 9216);
    const size_t row0 = (size_t)b * SEQ + (size_t)(n - 1) * CH;
    const int fr = lane & 15, fq = lane >> 4;
    gcl[lane] = GC[lane];
    LDS_WAIT();
#pragma unroll
    for (int mt = 0; mt < 4; ++mt) { const int c = 16 * mt + fr; bf16x8 X[4], Y[4][4];
#pragma unroll
        for (int ks = 0; ks < 4; ++ks) { X[ks] = *(const bf16x8*)(QH + c * 128 + 32 * ks + 8 * fq);
#pragma unroll
            for (int nt = 0; nt < 4; ++nt) if (nt <= mt) Y[nt][ks] = *(const bf16x8*)(KH + (16 * nt + fr) * 128 + 32 * ks + 8 * fq); }
        SB();
        const float gcc = gcl[c];
#pragma unroll
        for (int nt = 0; nt < 4; ++nt) { f32x4 acc = {0.f, 0.f, 0.f, 0.f}; const int s0 = 16 * nt + 4 * fq; const f32x4 gsv = *(const LAS f32x4*)(gcl + s0);
            if (nt <= mt) {
#pragma unroll
                for (int ks = 0; ks < 4; ++ks) acc = MFMA16(Y[nt][ks], X[ks], acc);
#pragma unroll
                for (int jj = 0; jj < 4; ++jj) { const float ev = __expf(fminf(gcc - gsv[jj], 0.f)); acc[jj] = (s0 + jj <= c) ? acc[jj] * ev : 0.f; } }
            *(LAS v2u*)(Ab + c * LD72 + s0) = (v2u){pk2(acc[0], acc[1]), pk2(acc[2], acc[3])}; }
        SB(); }
    LDS_WAIT();
#pragma unroll 1
    for (int mt = 0; mt < 4; ++mt) { const int c = 16 * mt + fr; bf16x8 XQ[4], XA[2]; f32x4 o[8];
        const float eg = __expf(gcl[c]);
        v2u rz[8];
#pragma unroll
        for (int nt = 0; nt < 8; ++nt) rz[nt] = *(const v2u*)(P + (row0 + c) * NIN + C_DZ + h * 128 + 16 * nt + 4 * fq);
#pragma unroll
        for (int ks = 0; ks < 4; ++ks) XQ[ks] = *(const bf16x8*)(QH + c * 128 + 32 * ks + 8 * fq);
#pragma unroll
        for (int ks = 0; ks < 2; ++ks) XA[ks] = *(const LAS bf16x8*)(Ab + c * LD72 + 32 * ks + 8 * fq);
#pragma unroll
        for (int qd = 0; qd < 4; ++qd) { bf16x8 YS[2][4], YV[2][2];
#pragma unroll
            for (int i = 0; i < 2; ++i) { const int nt = 2 * qd + i;
#pragma unroll
                for (int ks = 0; ks < 4; ++ks) YS[i][ks] = *(const bf16x8*)(SN + (16 * nt + fr) * 128 + 32 * ks + 8 * fq);
#pragma unroll
                for (int ks = 0; ks < 2; ++ks) YV[i][ks] = *(const bf16x8*)(VN + (16 * nt + fr) * 64 + 32 * ks + 8 * fq); }
            SB();
#pragma unroll
            for (int i = 0; i < 2; ++i) { f32x4 acc = {0.f, 0.f, 0.f, 0.f};
#pragma unroll
                for (int ks = 0; ks < 4; ++ks) acc = MFMA16(YS[i][ks], XQ[ks], acc);
                acc = acc * eg;
#pragma unroll
                for (int ks = 0; ks < 2; ++ks) acc = MFMA16(YV[i][ks], XA[ks], acc);
                o[2 * qd + i] = acc; }
            SB(); }
        float sq = 0.f;
#pragma unroll
        for (int nt = 0; nt < 8; ++nt) sq += (o[nt][0] * o[nt][0] + o[nt][1] * o[nt][1]) + (o[nt][2] * o[nt][2] + o[nt][3] * o[nt][3]);
        sq += __shfl_xor(sq, 16); sq += __shfl_xor(sq, 32);
        const float rstd = rsqrtf(sq * (1.f / 128.f) + EPS);
        { f32x4 gv[8];
#pragma unroll
          for (int nt = 0; nt < 8; ++nt) gv[nt] = *(const f32x4*)(a.dn_norm_g + 16 * nt + 4 * fq);
          SB();
#pragma unroll
          for (int nt = 0; nt < 8; ++nt) { const int e0 = 16 * nt + 4 * fq;
              const float r0 = o[nt][0] * rstd * gv[nt][0] * siluf_(bflo(rz[nt].x)), r1 = o[nt][1] * rstd * gv[nt][1] * siluf_(bfhi(rz[nt].x)), r2 = o[nt][2] * rstd * gv[nt][2] * siluf_(bflo(rz[nt].y)), r3 = o[nt][3] * rstd * gv[nt][3] * siluf_(bfhi(rz[nt].y));
              *(v2u*)(MIX + (row0 + c) * D + h * 128 + e0) = (v2u){pk2(r0, r1), pk2(r2, r3)}; }
          SB(); } }
    LDS_WAIT();
}

constexpr size_t WS_BAR = 974 * MiB;
#define XB_TMO      128
#define XB_XCNT(j)  (256  + 64 * (j))
#define XB_XSUB(j)  (1280 + 64 * (j))
#define XB_XGEN(j)  (2304 + 64 * (j))
#define XB_TOP      3328
#define XB_TOPGEN   3392
#define XCD_BAR_WORDS 3456
#define XB_SPIN_CAP (1u << 18)

__device__ __forceinline__ unsigned xb_ld(unsigned* p)              { return __hip_atomic_load(p, __ATOMIC_RELAXED, __HIP_MEMORY_SCOPE_AGENT); }
__device__ __forceinline__ unsigned xb_add(unsigned* p, unsigned v) { return __hip_atomic_fetch_add(p, v, __ATOMIC_RELAXED, __HIP_MEMORY_SCOPE_AGENT); }
__device__ __forceinline__ unsigned xb_xcc_id() { return (unsigned)__builtin_amdgcn_s_getreg((3 << 11) | 20) & 0xFu; }
#define XB_SPIN(cond, bar) do { unsigned _sp = 0; while (cond) { __builtin_amdgcn_s_sleep(1); \
    if ((++_sp & 255u) == 0u) { if (xb_ld(&(bar)[XB_TMO])) break; if (_sp > XB_SPIN_CAP) { atomicAdd(&(bar)[XB_TMO], 1u); break; } } } } while (0)

struct XcdBarrier {
    unsigned* bar; unsigned x;
    volatile LAS unsigned* st;
};

__device__ __forceinline__ XcdBarrier xcd_barrier_post(unsigned* bar, volatile LAS unsigned* st) {
    XcdBarrier b; b.bar = bar; b.x = xb_xcc_id(); b.st = st;
    if (threadIdx.x == 0) (void)xb_add(&bar[XB_XCNT(b.x)], 1u);
    return b;
}
__device__ __forceinline__ void xcd_barrier_complete(unsigned* bar, unsigned x, unsigned& nloc, unsigned& nx) {
    const unsigned G = gridDim.x * gridDim.y * gridDim.z;
    unsigned sum, cnt, mine, sp = 0u;
    for (;;) {
        sum = 0u; cnt = 0u; mine = 0u;
#pragma unroll
        for (unsigned j = 0; j < 16; ++j) { const unsigned c = xb_ld(&bar[XB_XCNT(j)]); sum += c; cnt += (c > 0u) ? 1u : 0u; mine = (j == x) ? c : mine; }
        if (sum == G) break;
        __builtin_amdgcn_s_sleep(1);
        if ((++sp & 255u) == 0u) { if (xb_ld(&bar[XB_TMO])) break; if (sp > XB_SPIN_CAP) { atomicAdd(&bar[XB_TMO], 1u); break; } }
    }
    nloc = mine > 0u ? mine : 1u; nx = cnt > 0u ? cnt : 1u;
}

__device__ __forceinline__ void xcd_barrier(const XcdBarrier& b) {
    asm volatile("s_waitcnt vmcnt(0)" ::: "memory");
    __syncthreads();
    if (threadIdx.x == 0) {
        unsigned* bar = b.bar;
        __builtin_amdgcn_s_waitcnt(0);
        unsigned nloc = b.st[0], nx = b.st[1];
        if (nloc == 0u) { xcd_barrier_complete(bar, b.x, nloc, nx); b.st[0] = nloc; b.st[1] = nx; }
        const unsigned old = xb_add(&bar[XB_XSUB(b.x)], 1u);
        const unsigned gen = old / nloc;
        if (old + 1u == (gen + 1u) * nloc) {
            __builtin_amdgcn_fence(__ATOMIC_RELEASE, "agent");
            asm volatile("s_waitcnt vmcnt(0)" ::: "memory");
            const unsigned og = xb_add(&bar[XB_TOP], 1u);
            const unsigned tg = og / nx;
            if (og + 1u == (tg + 1u) * nx) xb_add(&bar[XB_TOPGEN], 1u);
            else XB_SPIN(xb_ld(&bar[XB_TOPGEN]) == tg, bar);
            __builtin_amdgcn_fence(__ATOMIC_ACQUIRE, "agent");
            xb_add(&bar[XB_XGEN(b.x)], 1u);
            asm volatile("s_waitcnt vmcnt(0)" ::: "memory");
        } else {
            XB_SPIN(xb_ld(&bar[XB_XGEN(b.x)]) == gen, bar);
            __builtin_amdgcn_fence(__ATOMIC_ACQUIRE, "agent");
            asm volatile("s_waitcnt vmcnt(0)" ::: "memory");
        }
    }
    __syncthreads();
}

__device__ __forceinline__ int fresh_tid() { int t = threadIdx.x; asm volatile("" : "+v"(t)); return t; }
#define GASP __attribute__((address_space(1)))
#define PHASE_IDS const int tid = fresh_tid(), lane = tid & 63, wave = __builtin_amdgcn_readfirstlane(tid >> 6); const int gw = blockIdx.x * NWAVES + wave; (void)gw; (void)lane; (void)tid; \
    Args al = a; { GASP unsigned char* w_ = (GASP unsigned char*)a.ws; GASP float* o_ = (GASP float*)a.out; asm volatile("" : "+s"(w_), "+s"(o_)); al.ws = (unsigned char*)w_; al.out = (float*)o_; }
__global__ void __launch_bounds__(NTHREADS) hymba_fwd(Args a) {
    extern __shared__ __attribute__((aligned(16))) unsigned char lds_raw[];
    cg::grid_group grid = cg::this_grid();
    LAS unsigned char* lds = (LAS unsigned char*)lds_raw;
    const int G = gridDim.x, NGW = G * NWAVES;
    { volatile LAS unsigned* st = (volatile LAS unsigned*)(lds + 140288); if (threadIdx.x < 2) st[threadIdx.x] = 0u; }
    __syncthreads();
    const XcdBarrier xbar = xcd_barrier_post((unsigned*)(a.ws + WS_BAR), (volatile LAS unsigned*)(lds + 140288));

    { PHASE_IDS; p0_prologue(al, lds, tid, lane, wave); }
    grid.sync();
    { PHASE_IDS; pg8::Gemm g{(bf16*)(al.ws + WS_HN), (bf16*)(al.ws + WS_WIN), MR, NIN, D}; pg8::StaticOrder S; S.init(MR, NIN, G, (int)blockIdx.x);
      pg8::EpiBf16<0> E{(bf16*)(al.ws + WS_P), NIN, nullptr, 0, 0, 1.f};
      pg8::gemm_phase<pg8::EpiBf16<0>, pg8::StaticOrder, true, true>(lds, g, S, E); }
    xcd_barrier(xbar);
    { PHASE_IDS;
      for (int it = blockIdx.x; it < 4160 + 4096; it += G) {
          if (it < 4160) { const int bh = it / 65, n = it - bh * 65, b = bh >> 2, b2 = b < 8 ? 2 * b + 1 : 2 * (b - 8); dn_p2_item(al, ((b2 << 2) | (bh & 3)) * 65 + n, lds, tid, lane, wave); }
          else { const int ig = it - 4160, b = ig >> 8, b2 = b < 8 ? 2 * b + 1 : 2 * (b - 8); gla_p2_item(al, (b2 << 8) | (ig & 255), lds, tid, lane, wave); } } }
    xcd_barrier(xbar);
    { PHASE_IDS; const bool fuse = (G == 256);
      if (fuse) {
        for (int u = blockIdx.x; u < 256; u += G) dn_p3_unit<true, false>(al, u, lds, tid, lane, wave); }
      else { for (int u = blockIdx.x; u < 256; u += G) dn_p3_unit<false, false>(al, u, lds, tid, lane, wave); }
      if (!fuse) gla_p3_scan(al, tid); }
    xcd_barrier(xbar);
    { PHASE_IDS;
      for (int it = gw; it < 4096; it += NGW) dn_p4_wave(al, it, lds + wave * 9728, lane); }
    __syncthreads();
    { PHASE_IDS;
      for (int it = blockIdx.x; it < 4096; it += G) gla_p4_item(al, it, lds, tid, lane, wave); }
    xcd_barrier(xbar);
    { PHASE_IDS; pg8::Gemm g{(bf16*)(al.ws + WS_MIX), (bf16*)(al.ws + WS_WOUT), MR, D, D}; pg8::StaticOrder S; S.init(MR, D, G, (int)blockIdx.x);
      pg8::EpiResStats<false> E{al.x, (bf16*)(al.ws + WS_HN), (float*)(al.ws + WS_PS1), D};
      pg8::gemm_phase<pg8::EpiResStats<false>, pg8::StaticOrder, true, true>(lds, g, S, E); }
    xcd_barrier(xbar);
    { PHASE_IDS; pg8::Gemm g{(bf16*)(al.ws + WS_HN), (bf16*)(al.ws + WS_WUP), MR, FF, D}; pg8::StaticOrder S; S.init(MR, FF, G, (int)blockIdx.x);
      pg8::EpiRelu2Scaled E{(bf16*)(al.ws + WS_P), FF, (const float*)(al.ws + WS_PS1)};
      pg8::gemm_phase<pg8::EpiRelu2Scaled, pg8::StaticOrder, true, true>(lds, g, S, E); }
    xcd_barrier(xbar);
    { PHASE_IDS; pg8::Gemm g{(bf16*)(al.ws + WS_P), (bf16*)(al.ws + WS_WDN), MR, D, FF}; pg8::StaticOrder S; S.init(MR, D, G, (int)blockIdx.x);
      pg8::EpiResStats<true> E{(const bf16*)(al.ws + WS_HN), (bf16*)(al.ws + WS_MIX), (float*)(al.ws + WS_PS2), D};
      pg8::gemm_phase<pg8::EpiResStats<true>, pg8::StaticOrder, true, true>(lds, g, S, E); }
    xcd_barrier(xbar);
    { PHASE_IDS; const bf16* YB = (const bf16*)(al.ws + WS_MIX); const float* PS2 = (const float*)(al.ws + WS_PS2);
      const f32x4* gp = (const f32x4*)al.final_g; const f32x4 g0 = gp[2 * lane], g1 = gp[2 * lane + 1], g2 = gp[128 + 2 * lane], g3 = gp[128 + 2 * lane + 1];
      for (int m = gw; m < MR; m += NGW) final_row(YB + (size_t)m * D, PS2 + (size_t)m * 16, g0, g1, g2, g3, al.out + (size_t)m * D, lane); }
}

extern "C" void kernel_launch(void* const* d_in, const int* in_sizes, int n_in, void* d_out, int out_size, void* d_ws, size_t ws_size, hipStream_t stream) {
    static int grid = 0;
    if (grid == 0) {
        int dev = 0, cus = 0, per_cu = 0;
        hipGetDevice(&dev); hipDeviceGetAttribute(&cus, hipDeviceAttributeMultiprocessorCount, dev);
        hipFuncSetAttribute((const void*)hymba_fwd, hipFuncAttributeMaxDynamicSharedMemorySize, LDS_BYTES);
        hipOccupancyMaxActiveBlocksPerMultiprocessor(&per_cu, (const void*)hymba_fwd, NTHREADS, LDS_BYTES);
        if (per_cu < 1) per_cu = 1;
        grid = cus * (per_cu > 1 ? 1 : per_cu);
        (void)hipGetLastError();
    }
    Args a{};
    a.x = (const float*)d_in[0]; a.meta = (const float*)d_in[1]; a.norm1_g = (const float*)d_in[2]; a.w_in = (const float*)d_in[3]; a.conv_w = (const float*)d_in[4];
    a.a_log = (const float*)d_in[5]; a.dt_bias = (const float*)d_in[6]; a.dn_norm_g = (const float*)d_in[7]; a.gla_w2 = (const float*)d_in[8]; a.gla_b = (const float*)d_in[9];
    a.gla_norm_g = (const float*)d_in[10]; a.w_out = (const float*)d_in[11]; a.norm2_g = (const float*)d_in[12]; a.w_up = (const float*)d_in[13]; a.w_down = (const float*)d_in[14];
    a.final_g = (const float*)d_in[15]; a.out = (float*)d_out; a.ws = (unsigned char*)d_ws;
    (void)hipMemsetAsync((char*)d_ws + WS_BAR, 0, XCD_BAR_WORDS * 4, stream);
    void* args[] = {&a};
    hipError_t e = hipLaunchCooperativeKernel((const void*)hymba_fwd, dim3(grid), dim3(NTHREADS), args, LDS_BYTES, stream);
    if (e != hipSuccess) fprintf(stderr, "cooperative launch failed: %s (grid %d)\n", hipGetErrorString(e), grid);
}
```

```cpp
#include <hip/hip_runtime.h>
#include <hip/hip_cooperative_groups.h>
#include <cstdio>
#include <cstdint>
namespace cg = cooperative_groups;
namespace pg8 {
#define PG8_LAS __attribute__((address_space(3)))
typedef unsigned short bf16_t;
typedef short bf16x8 __attribute__((ext_vector_type(8)));
typedef float f32x4 __attribute__((ext_vector_type(4)));
typedef unsigned u32x4 __attribute__((ext_vector_type(4)));
constexpr int BM = 256, BK = 64, HALF = 128, HTB = HALF * BK * 2  , STAGE_BYTES = 8 * HTB, NXCD = 8, WGM = 8;

__host__ __device__ __forceinline__ int lds_byte(int r, int c) { const int st = (r >> 4) * 2 + (c >> 5), rr = r & 15, cc = c & 31, ob = rr * 64 + cc * 2; return st * 1024 + (ob ^ (((ob >> 9) & 1) << 5)); }
__host__ __device__ __forceinline__ void stage_rc(int b, int& R, int& C) { const int st = b / 1024, sb = b % 1024, swz = sb ^ (((sb >> 9) & 1) << 5); R = (st >> 1) * 16 + swz / 64; C = (st & 1) * 32 + (swz % 64) / 2; }
__host__ __device__ __forceinline__ int perm32(int rho) { const int n = rho >> 4, i = rho & 15; return 8 * (i >> 2) + 4 * n + (i & 3); }

struct Unit { int pm, pn; };
struct Gemm { const bf16_t* A; const bf16_t* Bt; int M, N, K; };

struct StaticOrder {
    int nM, nN, nwg, G, c;
    __host__ __device__ void init(int M, int N, int G_, int c_) { nM = M / BM; nN = N / BM; nwg = nM * nN; G = G_; c = c_; }
    __host__ __device__ bool next(int i, Unit& u) const {
        const long L = (long)i * G + c; if (L >= nwg) return false;
        int wgid = (int)L; { const int q = nwg / NXCD, r = nwg % NXCD, xcd = wgid % NXCD, off = wgid / NXCD; wgid = (xcd < r ? xcd * (q + 1) : r * (q + 1) + (xcd - r) * q) + off; }
        const int nig = WGM * nN, gid = wgid / nig, fm = gid * WGM, gsz = (nM - fm) < WGM ? (nM - fm) : WGM;
        u.pm = fm + ((wgid % nig) % gsz); u.pn = (wgid % nig) / gsz; return true;
    }
    __device__ __forceinline__ void a_ready(const Unit&) const {}
    __device__ __forceinline__ void done(const Unit&) const {}
};

__device__ __forceinline__ unsigned cvt_pk_bf16(float lo, float hi) { unsigned r; asm volatile("v_cvt_pk_bf16_f32 %0, %1, %2" : "=v"(r) : "v"(lo), "v"(hi)); return r; }
typedef float f32x2 __attribute__((ext_vector_type(2)));
__device__ __forceinline__ f32x2 gelu_pk(f32x2 v) {
    const f32x2 av = __builtin_elementwise_abs(v), d = av * 0.2316418882f + 1.0f;
    f32x2 t; t.x = __builtin_amdgcn_rcpf(d.x); t.y = __builtin_amdgcn_rcpf(d.y);
    f32x2 q = t * 0.5307027145f + (-0.7265760135f); q = q * t + 0.7107068705f; q = q * t + (-0.142248368f); q = q * t + 0.127414796f; q = q * t;
    const f32x2 s = (v * v) * (-0.72134752044f);
    f32x2 e; e.x = __builtin_amdgcn_exp2f(s.x); e.y = __builtin_amdgcn_exp2f(s.y);
    const f32x2 m = v * (q * e), r = v - m;
    f32x2 o; o.x = v.x < 0.f ? m.x : r.x; o.y = v.y < 0.f ? m.y : r.y; return o;
}

template <int ACT  > struct EpiBf16 {
    static constexpr bool PERM = true, AFTER_DRAIN = false; static_assert(ACT == 0 || ACT == 1, "EpiBf16: ACT is 0 (none) or 1 (gelu_pk)");
    bf16_t* O; int ldc; const float* bias; int split_cols; size_t split_stride; float scale0;
    __device__ __forceinline__ void operator()(const f32x4 (&acc)[2][2][4][2], const Unit& u, int wr, int wc, int fr, int fq) const {
        const int row0 = u.pm * BM + wr * 64 + fr; int colt = u.pn * BM; bf16_t* base = O;
        float sc = 1.f; if (split_cols) { const int t = colt / split_cols; base += (size_t)t * split_stride; colt -= t * split_cols; if (t == 0) sc = scale0; }
        const int col0 = colt + wc * 32 + 8 * fq, bcol0 = u.pn * BM + wc * 32 + 8 * fq;
        f32x4 bv[2][2];
#pragma unroll
        for (int bj = 0; bj < 2; ++bj)
#pragma unroll
            for (int n = 0; n < 2; ++n) bv[bj][n] = bias ? *(const f32x4*)(bias + bcol0 + bj * HALF + 4 * n) : (f32x4){0.f, 0.f, 0.f, 0.f};
#pragma unroll
        for (int ai = 0; ai < 2; ++ai)
#pragma unroll
            for (int m = 0; m < 4; ++m) { bf16_t* rowp = base + (size_t)(row0 + ai * HALF + m * 16) * ldc + col0;
#pragma unroll
                for (int bj = 0; bj < 2; ++bj) { f32x4 v0 = acc[ai][bj][m][0] + bv[bj][0], v1 = acc[ai][bj][m][1] + bv[bj][1];
                    if (ACT == 1) { f32x2 a = gelu_pk((f32x2){v0[0], v0[1]}), b = gelu_pk((f32x2){v0[2], v0[3]}), c = gelu_pk((f32x2){v1[0], v1[1]}), d = gelu_pk((f32x2){v1[2], v1[3]});
                        v0 = (f32x4){a.x, a.y, b.x, b.y}; v1 = (f32x4){c.x, c.y, d.x, d.y}; }
                    v0 = v0 * sc; v1 = v1 * sc; u32x4 w; w.x = cvt_pk_bf16(v0[0], v0[1]); w.y = cvt_pk_bf16(v0[2], v0[3]); w.z = cvt_pk_bf16(v1[0], v1[1]); w.w = cvt_pk_bf16(v1[2], v1[3]);
                    *(u32x4*)(rowp + bj * HALF) = w; } }
    }
};

struct EpiRelu2Bf16 {
    static constexpr bool PERM = true, AFTER_DRAIN = false;
    bf16_t* O; int ldc;
    __device__ __forceinline__ void operator()(const f32x4 (&acc)[2][2][4][2], const Unit& u, int wr, int wc, int fr, int fq) const {
        const int row0 = u.pm * BM + wr * 64 + fr; const int col0 = u.pn * BM + wc * 32 + 8 * fq;
#pragma unroll
        for (int ai = 0; ai < 2; ++ai)
#pragma unroll
            for (int m = 0; m < 4; ++m) { bf16_t* rowp = O + (size_t)(row0 + ai * HALF + m * 16) * ldc + col0;
#pragma unroll
                for (int bj = 0; bj < 2; ++bj) { f32x4 v0 = acc[ai][bj][m][0], v1 = acc[ai][bj][m][1];
#pragma unroll
                    for (int i = 0; i < 4; ++i) { float a0 = v0[i] > 0.f ? v0[i] : 0.f, a1 = v1[i] > 0.f ? v1[i] : 0.f; v0[i] = a0 * a0; v1[i] = a1 * a1; }
                    u32x4 w; w.x = cvt_pk_bf16(v0[0], v0[1]); w.y = cvt_pk_bf16(v0[2], v0[3]); w.z = cvt_pk_bf16(v1[0], v1[1]); w.w = cvt_pk_bf16(v1[2], v1[3]);
                    *(u32x4*)(rowp + bj * HALF) = w; } }
    }
};
struct EpiResF32 {
    static constexpr bool PERM = false, AFTER_DRAIN = false;
    const float* base; float* out; int ldc;
    __device__ __forceinline__ void operator()(const f32x4 (&acc)[2][2][4][2], const Unit& u, int wr, int wc, int fr, int fq) const {
        const int col0 = u.pn * BM + wc * 32 + 4 * fq;
#pragma unroll
        for (int ai = 0; ai < 2; ++ai)
#pragma unroll
            for (int m = 0; m < 4; ++m) { const size_t off = (size_t)(u.pm * BM + ai * HALF + wr * 64 + m * 16 + fr) * ldc + col0;
#pragma unroll
                for (int bj = 0; bj < 2; ++bj)
#pragma unroll
                    for (int n = 0; n < 2; ++n) { const f32x4 bs = *(const f32x4*)(base + off + bj * HALF + n * 16); *(f32x4*)(out + off + bj * HALF + n * 16) = bs + acc[ai][bj][m][n]; } }
    }
};
typedef unsigned u32x2 __attribute__((ext_vector_type(2)));
template <bool BASE_BF16> struct EpiResStats {
    static constexpr bool PERM = false, AFTER_DRAIN = false;
    const void* base; bf16_t* ob; float* PS; int ldc;
    __device__ __forceinline__ void operator()(const f32x4 (&acc)[2][2][4][2], const Unit& u, int wr, int wc, int fr, int fq) const {
        const int col0 = u.pn * BM + wc * 32 + 4 * fq;
#pragma unroll
        for (int ai = 0; ai < 2; ++ai)
#pragma unroll
            for (int m = 0; m < 4; ++m) { const int row = u.pm * BM + ai * HALF + wr * 64 + m * 16 + fr; const size_t off = (size_t)row * ldc + col0; float sq = 0.f;
                f32x4 bs[2][2];
#pragma unroll
                for (int bj = 0; bj < 2; ++bj)
#pragma unroll
                    for (int n = 0; n < 2; ++n) {
                        if (BASE_BF16) { const u32x2 w = *(const u32x2*)((const bf16_t*)base + off + bj * HALF + n * 16);
                            bs[bj][n] = (f32x4){__builtin_bit_cast(float, w.x << 16), __builtin_bit_cast(float, w.x & 0xffff0000u), __builtin_bit_cast(float, w.y << 16), __builtin_bit_cast(float, w.y & 0xffff0000u)}; }
                        else bs[bj][n] = *(const f32x4*)((const float*)base + off + bj * HALF + n * 16); }
#pragma unroll
                for (int bj = 0; bj < 2; ++bj)
#pragma unroll
                    for (int n = 0; n < 2; ++n) { const f32x4 v = bs[bj][n] + acc[ai][bj][m][n]; sq += (v[0] * v[0] + v[1] * v[1]) + (v[2] * v[2] + v[3] * v[3]);
                        u32x2 w; w.x = cvt_pk_bf16(v[0], v[1]); w.y = cvt_pk_bf16(v[2], v[3]); *(u32x2*)(ob + off + bj * HALF + n * 16) = w; }
                sq += __shfl_xor(sq, 16); sq += __shfl_xor(sq, 32);
                if (fq == 0) PS[(size_t)row * 16 + u.pn * 4 + wc] = sq; }
    }
};
struct EpiRelu2Scaled {
    static constexpr bool PERM = true, AFTER_DRAIN = false;
    bf16_t* O; int ldc; const float* PS;
    __device__ __forceinline__ void operator()(const f32x4 (&acc)[2][2][4][2], const Unit& u, int wr, int wc, int fr, int fq) const {
        const int row0 = u.pm * BM + wr * 64 + fr; const int col0 = u.pn * BM + wc * 32 + 8 * fq;
        float rs[2][4];
#pragma unroll
        for (int ai = 0; ai < 2; ++ai)
#pragma unroll
            for (int m = 0; m < 4; ++m) { const f32x4* pp = (const f32x4*)(PS + (size_t)(row0 + ai * HALF + m * 16) * 16); const f32x4 a0 = pp[0], a1 = pp[1], a2 = pp[2], a3 = pp[3];
                const float s = ((a0[0] + a0[1]) + (a0[2] + a0[3])) + ((a1[0] + a1[1]) + (a1[2] + a1[3])) + ((a2[0] + a2[1]) + (a2[2] + a2[3])) + ((a3[0] + a3[1]) + (a3[2] + a3[3]));
                rs[ai][m] = __builtin_amdgcn_rsqf(s * (1.0f / 1024.0f) + 1e-6f); }
#pragma unroll
        for (int ai = 0; ai < 2; ++ai)
#pragma unroll
            for (int m = 0; m < 4; ++m) { bf16_t* rowp = O + (size_t)(row0 + ai * HALF + m * 16) * ldc + col0; const float r = rs[ai][m];
#pragma unroll
                for (int bj = 0; bj < 2; ++bj) { f32x4 v0 = acc[ai][bj][m][0] * r, v1 = acc[ai][bj][m][1] * r;
#pragma unroll
                    for (int i = 0; i < 4; ++i) { float a0 = v0[i] > 0.f ? v0[i] : 0.f, a1 = v1[i] > 0.f ? v1[i] : 0.f; v0[i] = a0 * a0; v1[i] = a1 * a1; }
                    u32x4 w; w.x = cvt_pk_bf16(v0[0], v0[1]); w.y = cvt_pk_bf16(v0[2], v0[3]); w.z = cvt_pk_bf16(v1[0], v1[1]); w.w = cvt_pk_bf16(v1[2], v1[3]);
                    *(u32x4*)(rowp + bj * HALF) = w; } }
    }
};
struct EpiBf16Blocked {
    static constexpr bool PERM = true, AFTER_DRAIN = false;
    bf16_t* O; int ncb;
    __device__ __forceinline__ void operator()(const f32x4 (&acc)[2][2][4][2], const Unit& u, int wr, int wc, int fr, int fq) const {
        const int row0 = u.pm * BM + wr * 64 + fr; const int col0 = u.pn * BM + wc * 32 + 8 * fq;
#pragma unroll
        for (int ai = 0; ai < 2; ++ai)
#pragma unroll
            for (int m = 0; m < 4; ++m) { const int row = row0 + ai * HALF + m * 16;
#pragma unroll
                for (int bj = 0; bj < 2; ++bj) { const int col = col0 + bj * HALF; const f32x4 v0 = acc[ai][bj][m][0], v1 = acc[ai][bj][m][1];
                    u32x4 w; w.x = cvt_pk_bf16(v0[0], v0[1]); w.y = cvt_pk_bf16(v0[2], v0[3]); w.z = cvt_pk_bf16(v1[0], v1[1]); w.w = cvt_pk_bf16(v1[2], v1[3]);
                    *(u32x4*)(O + ((((size_t)(row >> 6) * ncb + (col >> 6)) * 64 + (row & 63)) * 64 + (col & 63))) = w; } }
    }
};
template <class Epi, class Sched, bool ALIGN_EPI = false, bool SP2 = false>
__device__ __forceinline__ void gemm_phase(PG8_LAS unsigned char* lds, const Gemm g, const Sched& S, const Epi& E) {
    int tid_ = threadIdx.x; asm volatile("" : "+v"(tid_)); const int tid = tid_, wid = __builtin_amdgcn_readfirstlane(tid >> 6), lane = tid & 63, wr = wid >> 2, wc = wid & 3, fr = lane & 15, fq = lane >> 4;
    const int K = g.K, nt = K / BK;
    unsigned voffA[2], voffB[2];
#pragma unroll
    for (int i = 0; i < 2; ++i) { int R, C; stage_rc(tid * 16 + i * 8192, R, C); const int Rb = Epi::PERM ? ((R & ~31) + perm32(R & 31)) : R;
        voffA[i] = (unsigned)(R * K + C) * 2u; voffB[i] = (unsigned)(Rb * K + C) * 2u; }
    const size_t kstep = (size_t)(BK * 2);
    const size_t hstep = (size_t)HALF * K * 2;
    const size_t tstep = 2 * hstep;
    const unsigned ldsw = (unsigned)wid * 1024u;
    const int aoff = lds_byte(wr * 64 + fr, fq * 8), boff = lds_byte(wc * 32 + fr, fq * 8);
#define PG8_SA(b, h) (((b) * 2 + (h)) * HTB)
#define PG8_SB(b, h) ((4 + (b) * 2 + (h)) * HTB)
#define PG8_STAGE(bufoff, gbase, voff) do { _Pragma("unroll") for (int _i = 0; _i < 2; ++_i) \
        __builtin_amdgcn_global_load_lds((const unsigned*)((const char*)(gbase) + (voff)[_i]), (PG8_LAS unsigned*)(lds + (bufoff) + ldsw + _i * 8192), 16, 0, 0); } while (0)
#define PG8_LDA(dst, b, h) do { _Pragma("unroll") for (int m = 0; m < 4; ++m) _Pragma("unroll") for (int k = 0; k < 2; ++k) dst[m][k] = *(const PG8_LAS bf16x8*)(lds + PG8_SA(b, h) + aoff + m * 2048 + k * 1024); } while (0)
#define PG8_LDB(dst, b, h) do { _Pragma("unroll") for (int n = 0; n < 2; ++n) _Pragma("unroll") for (int k = 0; k < 2; ++k) dst[n][k] = *(const PG8_LAS bf16x8*)(lds + PG8_SB(b, h) + boff + n * 2048 + k * 1024); } while (0)
#define PG8_MMA(ai, bj, At, Bt) do { __builtin_amdgcn_s_setprio(1); _Pragma("unroll") for (int m = 0; m < 4; ++m) _Pragma("unroll") for (int n = 0; n < 2; ++n) _Pragma("unroll") for (int k = 0; k < 2; ++k) \
        acc[ai][bj][m][n] = __builtin_amdgcn_mfma_f32_16x16x32_bf16(Bt[n][k], At[m][k], acc[ai][bj][m][n], 0, 0, 0); __builtin_amdgcn_s_setprio(0); } while (0)
#define PG8_WAIT_V(n) asm volatile("s_waitcnt vmcnt(" #n ")" ::: "memory")
#define PG8_WAIT_L(n) asm volatile("s_waitcnt lgkmcnt(" #n ")" ::: "memory")
#define PG8_BAR __builtin_amdgcn_s_barrier()
#define PG8_SCHED __builtin_amdgcn_sched_barrier(0)
    Unit cur, nxt; int ui = 0;
    if (!S.next(0, cur)) return;
    f32x4 acc[2][2][4][2];
#pragma unroll
    for (int a = 0; a < 2; ++a)
#pragma unroll
        for (int b = 0; b < 2; ++b)
#pragma unroll
            for (int m = 0; m < 4; ++m)
#pragma unroll
                for (int n = 0; n < 2; ++n) acc[a][b][m][n] = (f32x4){0.f, 0.f, 0.f, 0.f};
    bf16x8 At[4][2], B0[2][2], B1[2][2];
    const char* cA = (const char*)g.A + (size_t)cur.pm * tstep; const char* cB = (const char*)g.Bt + (size_t)cur.pn * tstep;
    S.a_ready(cur);
    if constexpr (SP2) {
        PG8_STAGE(PG8_SB(0, 0), cB, voffB); PG8_STAGE(PG8_SB(0, 1), cB + hstep, voffB); PG8_STAGE(PG8_SA(0, 0), cA, voffA); PG8_STAGE(PG8_SA(0, 1), cA + hstep, voffA);
        if (wr == 1) PG8_BAR;
        PG8_WAIT_V(2); PG8_BAR;
        PG8_STAGE(PG8_SB(1, 0), cB + kstep, voffB); PG8_STAGE(PG8_SA(1, 0), cA + kstep, voffA); PG8_STAGE(PG8_SB(1, 1), cB + hstep + kstep, voffB);
        PG8_WAIT_V(6); PG8_BAR;
    } else {
        PG8_STAGE(PG8_SB(0, 0), cB, voffB); PG8_STAGE(PG8_SA(0, 0), cA, voffA); PG8_STAGE(PG8_SB(0, 1), cB + hstep, voffB); PG8_STAGE(PG8_SA(0, 1), cA + hstep, voffA);
        if (wr == 1) PG8_BAR;
        PG8_WAIT_V(4); PG8_BAR;
        PG8_STAGE(PG8_SB(1, 0), cB + kstep, voffB); PG8_STAGE(PG8_SA(1, 0), cA + kstep, voffA); PG8_STAGE(PG8_SB(1, 1), cB + hstep + kstep, voffB);
        PG8_WAIT_V(6); PG8_BAR;
    }
    for (;;) {
        const bool has_next = S.next(ui + 1, nxt);
        const char* nA = has_next ? (const char*)g.A + (size_t)nxt.pm * tstep : cA; const char* nB = has_next ? (const char*)g.Bt + (size_t)nxt.pn * tstep : cB;
        for (int t = 0; t < nt; t += 2) {
            const bool last = (t == nt - 2);
            const char* a1 = cA + (size_t)(t + 1) * kstep;
            const char* a2 = last ? nA : cA + (size_t)(t + 2) * kstep; const char* b2 = last ? nB : cB + (size_t)(t + 2) * kstep;
            const char* a3 = a2 + kstep; const char* b3 = b2 + kstep;
            if (last && has_next) S.a_ready(nxt);
            if constexpr (SP2) {
            PG8_LDB(B0, 0, 0); PG8_LDB(B1, 0, 1); PG8_SCHED; PG8_LDA(At, 0, 0); PG8_STAGE(PG8_SA(1, 1), a1 + hstep, voffA);
            PG8_WAIT_V(8); PG8_WAIT_L(0); PG8_BAR; PG8_MMA(0, 0, At, B0); PG8_MMA(0, 1, At, B1); PG8_BAR; PG8_SCHED;
            PG8_LDA(At, 0, 1); PG8_STAGE(PG8_SB(0, 0), b2, voffB); PG8_STAGE(PG8_SB(0, 1), b2 + hstep, voffB); PG8_STAGE(PG8_SA(0, 0), a2, voffA);
            PG8_WAIT_V(8); PG8_WAIT_L(0); PG8_BAR; PG8_MMA(1, 0, At, B0); PG8_MMA(1, 1, At, B1); PG8_BAR; PG8_SCHED;
            PG8_LDB(B0, 1, 0); PG8_LDB(B1, 1, 1); PG8_SCHED; PG8_LDA(At, 1, 0); PG8_STAGE(PG8_SA(0, 1), a2 + hstep, voffA);
            PG8_WAIT_V(8); PG8_WAIT_L(0); PG8_BAR; PG8_MMA(0, 0, At, B0); PG8_MMA(0, 1, At, B1); PG8_BAR; PG8_SCHED;
            PG8_LDA(At, 1, 1); PG8_STAGE(PG8_SB(1, 0), b3, voffB); PG8_STAGE(PG8_SB(1, 1), b3 + hstep, voffB); PG8_STAGE(PG8_SA(1, 0), a3, voffA);
            PG8_WAIT_V(8); PG8_WAIT_L(0); PG8_BAR; PG8_MMA(1, 0, At, B0); PG8_MMA(1, 1, At, B1); PG8_BAR; PG8_SCHED;
            } else {
            PG8_LDB(B0, 0, 0); PG8_SCHED; PG8_LDA(At, 0, 0); PG8_STAGE(PG8_SA(1, 1), a1 + hstep, voffA);
            PG8_WAIT_L(8); PG8_BAR; PG8_WAIT_L(0); PG8_MMA(0, 0, At, B0); PG8_BAR; PG8_SCHED;
            PG8_LDB(B1, 0, 1); PG8_STAGE(PG8_SB(0, 0), b2, voffB);
            PG8_BAR; PG8_WAIT_L(0); PG8_MMA(0, 1, At, B1); PG8_BAR;
            PG8_LDA(At, 0, 1); PG8_STAGE(PG8_SA(0, 0), a2, voffA);
            PG8_BAR; PG8_WAIT_L(0); PG8_MMA(1, 0, At, B0); PG8_BAR; PG8_SCHED;
            PG8_STAGE(PG8_SB(0, 1), b2 + hstep, voffB);
            PG8_WAIT_V(6); PG8_BAR; PG8_MMA(1, 1, At, B1); PG8_BAR;
            PG8_LDB(B0, 1, 0); PG8_SCHED; PG8_LDA(At, 1, 0); PG8_STAGE(PG8_SA(0, 1), a2 + hstep, voffA);
            PG8_WAIT_L(8); PG8_BAR; PG8_WAIT_L(0); PG8_MMA(0, 0, At, B0); PG8_BAR; PG8_SCHED;
            PG8_LDB(B1, 1, 1); PG8_STAGE(PG8_SB(1, 0), b3, voffB);
            PG8_BAR; PG8_WAIT_L(0); PG8_MMA(0, 1, At, B1); PG8_BAR;
            PG8_LDA(At, 1, 1); PG8_STAGE(PG8_SA(1, 0), a3, voffA);
            PG8_BAR; PG8_WAIT_L(0); PG8_MMA(1, 0, At, B0); PG8_BAR; PG8_SCHED;
            PG8_STAGE(PG8_SB(1, 1), b3 + hstep, voffB);
            PG8_WAIT_V(6); PG8_BAR; PG8_MMA(1, 1, At, B1); PG8_BAR;
            }
        }
        if constexpr (ALIGN_EPI) { if (wr == 0) PG8_BAR; }
        if constexpr (!Epi::AFTER_DRAIN) { E(acc, cur, wr, wc, fr, fq); S.done(cur); }
        if (!has_next) break;
#pragma unroll
        for (int a = 0; a < 2; ++a)
#pragma unroll
            for (int b = 0; b < 2; ++b)
#pragma unroll
                for (int m = 0; m < 4; ++m)
#pragma unroll
                    for (int n = 0; n < 2; ++n) acc[a][b][m][n] = (f32x4){0.f, 0.f, 0.f, 0.f};
        cur = nxt; cA = nA; cB = nB; ++ui;
        if constexpr (ALIGN_EPI) { if (wr == 1) PG8_BAR; }
    }
    PG8_WAIT_V(0);
    if constexpr (!ALIGN_EPI) { if (wr == 0) PG8_BAR; }
    PG8_BAR;
    if constexpr (Epi::AFTER_DRAIN) { E.fused(acc, cur, wr, wc, fr, fq, lds, wid, lane); S.done(cur); }
#undef PG8_SA
#undef PG8_SB
#undef PG8_STAGE
#undef PG8_LDA
#undef PG8_LDB
#undef PG8_MMA
#undef PG8_WAIT_V
#undef PG8_WAIT_L
#undef PG8_BAR
#undef PG8_SCHED
}
}
#define LAS __attribute__((address_space(3)))
typedef unsigned short bf16;
typedef float f32x4 __attribute__((ext_vector_type(4)));
typedef unsigned v4u __attribute__((ext_vector_type(4)));
typedef unsigned v2u __attribute__((ext_vector_type(2)));
#define LDS_WAIT() asm volatile("s_waitcnt lgkmcnt(0)" ::: "memory")

constexpr int NWAVES = 8, NTHREADS = 512;
constexpr int BATCH = 16, SEQ = 4096, D = 1024, FF = 4096, CH = 64, TTOT = SEQ + CH, NPAD = 48;
constexpr int MR = BATCH * SEQ;
constexpr int PROWS = MR + CH;
constexpr int NIN = 3840, NIN_SRC = 3608;
constexpr int C_DQ = 0, C_DK = 512, C_DV = 1024, C_DZ = 1536, C_GQ = 2048, C_GK = 2304, C_GV = 2560, C_GR = 3072, C_BETA = 3584, C_A = 3588, C_LR = 3592;
constexpr float EPS = 1e-6f;
constexpr size_t MiB = 1u << 20;
constexpr size_t WS_WIN = 0, WS_WOUT = 8 * MiB, WS_WUP = 10 * MiB, WS_WDN = 18 * MiB, WS_HN = 32 * MiB, WS_MIX = 160 * MiB, WS_P = 288 * MiB;
constexpr size_t WS_PS1 = 976 * MiB, WS_PS2 = 982 * MiB;
constexpr int LDS_BYTES = 147456;

struct Args {
    const float *x, *meta, *norm1_g, *w_in, *conv_w, *a_log, *dt_bias, *dn_norm_g, *gla_w2, *gla_b, *gla_norm_g, *w_out, *norm2_g, *w_up, *w_down, *final_g;
    float* out; unsigned char* ws;
};

typedef __bf16 bf16v2_t __attribute__((ext_vector_type(2)));
typedef float f32v2_t __attribute__((ext_vector_type(2)));
__device__ __forceinline__ unsigned pk2(float lo, float hi) { const f32v2_t v = {lo, hi}; const bf16v2_t b = __builtin_convertvector(v, bf16v2_t); return __builtin_bit_cast(unsigned, b); }
__device__ __forceinline__ unsigned f2bf(float f) { return pk2(f, 0.f) & 0xffffu; }
__device__ __forceinline__ float bf2f(unsigned short h) { return __builtin_bit_cast(float, (unsigned)h << 16); }
__device__ __forceinline__ float bflo(unsigned w) { return __builtin_bit_cast(float, w << 16); }
__device__ __forceinline__ float bfhi(unsigned w) { return __builtin_bit_cast(float, w & 0xffff0000u); }
__device__ __forceinline__ float wave_sum(float v) {
#pragma unroll
    for (int o = 1; o < 64; o <<= 1) v += __shfl_xor(v, o);
    return v;
}
__device__ __forceinline__ float sigmoidf_(float x) { return __builtin_amdgcn_rcpf(1.f + __expf(-x)); }
__device__ __forceinline__ float siluf_(float x) { return x * __builtin_amdgcn_rcpf(1.f + __expf(-x)); }
__device__ __forceinline__ float softplusf_(float x) { return fmaxf(x, 0.f) + __logf(1.f + __expf(-fabsf(x))); }
__device__ __forceinline__ float logsigmoidf_(float x) { return fminf(x, 0.f) - __logf(1.f + __expf(-fabsf(x))); }
__device__ __forceinline__ size_t rowof(int b, int t) { return t < CH ? (size_t)(MR + t) : (size_t)(b * SEQ + t - CH); }

__device__ __forceinline__ int win_src(int n) { return n < 2048 ? n : (n < 3584 ? n + 8 : (n < 3592 ? n - 1536 : (n < 3608 ? n : -1))); }

template <bool MAP> __device__ __forceinline__ void transpose_item(const float* W, int K, int Nsrc, bf16* WT, LAS float* scr, int kb, int nb, int lane, const float* kscale = nullptr) {
    const int k0 = 64 * kb, n0 = 32 * nb;
    const int nn = n0 + (lane & 31); const int src = MAP ? win_src(nn) : nn;
#pragma unroll
    for (int i = 0; i < 32; ++i) { const int kk = 2 * i + (lane >> 5); float wv = src >= 0 ? W[(size_t)(k0 + kk) * Nsrc + src] : 0.f; if (kscale) wv *= kscale[k0 + kk]; scr[kk * 33 + (lane & 31)] = wv; }
    LDS_WAIT();
    const int c = lane & 7;
#pragma unroll
    for (int j = 0; j < 4; ++j) { const int n = (lane >> 3) + 8 * j; const LAS float* s = scr + (8 * c) * 33 + n;
        v4u o; o.x = pk2(s[0 * 33], s[1 * 33]); o.y = pk2(s[2 * 33], s[3 * 33]); o.z = pk2(s[4 * 33], s[5 * 33]); o.w = pk2(s[6 * 33], s[7 * 33]);
        *(v4u*)(WT + (size_t)(n0 + n) * K + k0 + 8 * c) = o; }
    LDS_WAIT();
}
__device__ __forceinline__ void rms_row_to_bf16(const float* xrow, const float* g, bf16* orow, int lane) {
    const f32x4* xr = (const f32x4*)xrow + lane; f32x4 v[4]; float s = 0.f;
#pragma unroll
    for (int j = 0; j < 4; ++j) { v[j] = xr[64 * j]; s += (v[j].x * v[j].x + v[j].y * v[j].y) + (v[j].z * v[j].z + v[j].w * v[j].w); }
    const float rstd = rsqrtf(wave_sum(s) * (1.f / D) + EPS);
    unsigned long long* o8 = (unsigned long long*)orow + lane;
#pragma unroll
    for (int j = 0; j < 4; ++j) { const f32x4 gv = ((const f32x4*)g)[lane + 64 * j];
        o8[64 * j] = (unsigned long long)pk2(v[j].x * rstd * gv.x, v[j].y * rstd * gv.y) | ((unsigned long long)pk2(v[j].z * rstd * gv.z, v[j].w * rstd * gv.w) << 32); }
}
__device__ __forceinline__ void final_row(const bf16* yrow, const float* ps, const f32x4 g0, const f32x4 g1, const f32x4 g2, const f32x4 g3, float* orow, int lane) {
    const f32x4 p0 = ((const f32x4*)ps)[0], p1 = ((const f32x4*)ps)[1], p2 = ((const f32x4*)ps)[2], p3 = ((const f32x4*)ps)[3];
    const float s = ((p0[0] + p0[1]) + (p0[2] + p0[3])) + ((p1[0] + p1[1]) + (p1[2] + p1[3])) + ((p2[0] + p2[1]) + (p2[2] + p2[3])) + ((p3[0] + p3[1]) + (p3[2] + p3[3]));
    const float rstd = rsqrtf(s * (1.f / D) + EPS);
    const v4u y0 = ((const v4u*)yrow)[lane], y1 = ((const v4u*)yrow)[lane + 64];
    f32x4* op = (f32x4*)orow;
    op[2 * lane] = (f32x4){bflo(y0.x), bfhi(y0.x), bflo(y0.y), bfhi(y0.y)} * rstd * g0; op[2 * lane + 1] = (f32x4){bflo(y0.z), bfhi(y0.z), bflo(y0.w), bfhi(y0.w)} * rstd * g1;
    op[128 + 2 * lane] = (f32x4){bflo(y1.x), bfhi(y1.x), bflo(y1.y), bfhi(y1.y)} * rstd * g2; op[128 + 2 * lane + 1] = (f32x4){bflo(y1.z), bfhi(y1.z), bflo(y1.w), bfhi(y1.w)} * rstd * g3;
}

__device__ __forceinline__ void p0_prologue(const Args& a, LAS unsigned char* lds, int tid, int lane, int wave) {
    unsigned char* ws = a.ws;
    bf16* Win_t = (bf16*)(ws + WS_WIN); bf16* Wout_t = (bf16*)(ws + WS_WOUT); bf16* Wup_t = (bf16*)(ws + WS_WUP); bf16* Wdn_t = (bf16*)(ws + WS_WDN);
    bf16* HN = (bf16*)(ws + WS_HN); bf16* P = (bf16*)(ws + WS_P);
    const int G = gridDim.x, gw = blockIdx.x * NWAVES + wave, NGW = G * NWAVES;
    LAS float* scr = (LAS float*)(lds + wave * 16384);
    constexpr int I_IN = 16 * (NIN / 32), I_OUT = 16 * (D / 32), I_UP = 16 * (FF / 32), I_DN = (FF / 64) * (D / 32);
    constexpr int NITEMS = I_IN + I_OUT + I_UP + I_DN;
    for (int it = gw; it < NITEMS; it += NGW) {
        int r = it;
        if (r < I_IN) { transpose_item<true>(a.w_in, D, NIN_SRC, Win_t, scr, r / (NIN / 32), r % (NIN / 32), lane); continue; } r -= I_IN;
        if (r < I_OUT) { transpose_item<false>(a.w_out, D, D, Wout_t, scr, r / (D / 32), r % (D / 32), lane); continue; } r -= I_OUT;
        if (r < I_UP) { transpose_item<false>(a.w_up, D, FF, Wup_t, scr, r / (FF / 32), r % (FF / 32), lane, a.norm2_g); continue; } r -= I_UP;
        transpose_item<false>(a.w_down, FF, D, Wdn_t, scr, r / (D / 32), r % (D / 32), lane);
    }
    for (int m = gw; m < MR; m += NGW) rms_row_to_bf16(a.x + (size_t)m * D, a.norm1_g, HN + (size_t)m * D, lane);
    { v4u z = {0u, 0u, 0u, 0u}; v4u* pz = (v4u*)(P + (size_t)MR * NIN);
      for (int i = blockIdx.x * NTHREADS + tid; i < NPAD * NIN / 8; i += G * NTHREADS) pz[i] = z; }
    __syncthreads();
    LAS float* hm = (LAS float*)lds;
#pragma unroll
    for (int rr = 0; rr < 2; ++rr) { const int r = wave * 2 + rr; const f32x4* xr = (const f32x4*)(a.meta + (size_t)r * D) + lane; f32x4 v[4]; float s = 0.f;
#pragma unroll
        for (int j = 0; j < 4; ++j) { v[j] = xr[64 * j]; s += (v[j].x * v[j].x + v[j].y * v[j].y) + (v[j].z * v[j].z + v[j].w * v[j].w); }
        const float rstd = rsqrtf(wave_sum(s) * (1.f / D) + EPS);
#pragma unroll
        for (int j = 0; j < 4; ++j) { const f32x4 gv = ((const f32x4*)a.norm1_g)[lane + 64 * j]; ((LAS f32x4*)(hm + r * D))[lane + 64 * j] = v[j] * rstd * gv; } }
    __syncthreads();
    for (int cb = blockIdx.x; cb * 15 < NIN; cb += G) {
        const int j = tid >> 5, ks = tid & 31; const int n = cb * 15 + j; const int src = (j < 15 && n < NIN) ? win_src(n) : -1;
        float acc[16];
#pragma unroll
        for (int r = 0; r < 16; ++r) acc[r] = 0.f;
        if (src >= 0) {
            for (int kk = 0; kk < 32; ++kk) { const int k = kk * 32 + ks; const float w = a.w_in[(size_t)k * NIN_SRC + src];
#pragma unroll
                for (int r = 0; r < 16; ++r) acc[r] += hm[r * D + k] * w; }
        }
#pragma unroll
        for (int r = 0; r < 16; ++r) { float v = acc[r]; v += __shfl_xor(v, 1); v += __shfl_xor(v, 2); v += __shfl_xor(v, 4); v += __shfl_xor(v, 8); v += __shfl_xor(v, 16); acc[r] = v; }
        float val = 0.f;
#pragma unroll
        for (int r = 0; r < 16; ++r) if (ks == r) val = acc[r];
        if (j < 15 && n < NIN && ks < 16) P[(size_t)(MR + NPAD + ks) * NIN + n] = (bf16)f2bf(val);
    }
    __syncthreads();
}

typedef short bf16x8 __attribute__((ext_vector_type(8)));
#define MFMA16(A_, B_, C_) __builtin_amdgcn_mfma_f32_16x16x32_bf16(A_, B_, C_, 0, 0, 0)
#define SB() __builtin_amdgcn_sched_barrier(0)
#define LBAR() do { asm volatile("s_waitcnt lgkmcnt(0)" ::: "memory"); __builtin_amdgcn_s_barrier(); asm volatile("" ::: "memory"); } while (0)
constexpr size_t WS_QH = 32 * MiB, WS_KH = 96 * MiB;
constexpr size_t WS_KT = 770 * MiB, WS_W = 836 * MiB, WS_UT = 902 * MiB, WS_GC = 968 * MiB, WS_GL = 970 * MiB;
constexpr size_t OUT_SN = 0, OUT_DS = 128 * MiB;
constexpr int LD72 = 72;

struct GlaRaw { v4u L0, L1; float w2[16]; float bias; };
__device__ __forceinline__ void gla_gates_load(const Args& a, const bf16* P, int b, int h, int n, int wave, int lane, GlaRaw& r) {
#pragma unroll
    for (int i = 0; i < 16; ++i) r.w2[i] = a.gla_w2[i * 256 + h * 64 + lane];
    r.bias = a.gla_b[h * 64 + lane];
    const bf16* pr = P + rowof(b, n * CH + wave * 8 + (lane & 7)) * NIN; r.L0 = *(const v4u*)(pr + C_LR); r.L1 = *(const v4u*)(pr + C_LR + 8);
}
__device__ __forceinline__ unsigned rdlane(unsigned v, int l) { return (unsigned)__builtin_amdgcn_readlane((int)v, l); }
__device__ __forceinline__ void gla_gates_compute(const GlaRaw& r, int n, int wave, int lane, LAS float* gs, float (&bc)[8], float& blast, float& bref) {
    float run = 0.f;
#pragma unroll
    for (int i = 0; i < 8; ++i) { const int t = n * CH + wave * 8 + i;
        v4u l0, l1; l0.x = rdlane(r.L0.x, i); l0.y = rdlane(r.L0.y, i); l0.z = rdlane(r.L0.z, i); l0.w = rdlane(r.L0.w, i); l1.x = rdlane(r.L1.x, i); l1.y = rdlane(r.L1.y, i); l1.z = rdlane(r.L1.z, i); l1.w = rdlane(r.L1.w, i);
        float x = r.bias;
        x += bflo(l0.x) * r.w2[0] + bfhi(l0.x) * r.w2[1] + bflo(l0.y) * r.w2[2] + bfhi(l0.y) * r.w2[3] + bflo(l0.z) * r.w2[4] + bfhi(l0.z) * r.w2[5] + bflo(l0.w) * r.w2[6] + bfhi(l0.w) * r.w2[7];
        x += bflo(l1.x) * r.w2[8] + bfhi(l1.x) * r.w2[9] + bflo(l1.y) * r.w2[10] + bfhi(l1.y) * r.w2[11] + bflo(l1.z) * r.w2[12] + bfhi(l1.z) * r.w2[13] + bflo(l1.w) * r.w2[14] + bfhi(l1.w) * r.w2[15];
        float g = logsigmoidf_(x) * (1.f / 16.f); if (t < NPAD) g = 0.f;
        run += g; bc[i] = run; }
    gs[wave * 64 + lane] = run; gs[512 + wave * 64 + lane] = bc[0];
    LBAR();
    float tv[8];
#pragma unroll
    for (int w = 0; w < 8; ++w) tv[w] = gs[w * 64 + lane];
    const float f4 = gs[512 + 4 * 64 + lane];
    float off = 0.f, tot = 0.f, br = 0.f;
#pragma unroll
    for (int w = 0; w < 8; ++w) { if (w < wave) off += tv[w]; if (w < 4) br += tv[w]; tot += tv[w]; }
    br += f4;
#pragma unroll
    for (int i = 0; i < 8; ++i) bc[i] += off;
    blast = tot; bref = br;
}
__device__ __forceinline__ void load_v_raw(const bf16* P, int b, int n, int vcol0, int tid, unsigned short (&vr)[16]) {
    const int e = tid & 127, cg4 = tid >> 7;
#pragma unroll
    for (int i = 0; i < 16; ++i) vr[i] = P[rowof(b, n * CH + cg4 * 16 + i) * NIN + vcol0 + e];
}
__device__ __forceinline__ void store_vT(const unsigned short (&vr)[16], LAS bf16* vT, int tid) {
    const int e = tid & 127, cg4 = tid >> 7; unsigned pk[8];
#pragma unroll
    for (int i = 0; i < 8; ++i) pk[i] = (unsigned)vr[2 * i] | ((unsigned)vr[2 * i + 1] << 16);
    LAS v4u* dst = (LAS v4u*)(vT + e * LD72 + cg4 * 16);
    dst[0] = (v4u){pk[0], pk[1], pk[2], pk[3]}; dst[1] = (v4u){pk[4], pk[5], pk[6], pk[7]};
}
constexpr int GL_VT = 0, GL_KDT = 18432, GL_QI = 18432, GL_KI = 27648, GL_QG = 36864, GL_AB = 46080, GL_GS = 55296, GL_SS = 59392;

__device__ __forceinline__ void gla_p2_item(const Args& a, int item, LAS unsigned char* lds, int tid, int lane, int wave) {
    const int n = item & 63, h = (item >> 6) & 3, b = item >> 8;
    const bf16* P = (const bf16*)(a.ws + WS_P);
    float* DS = (float*)((unsigned char*)a.out + OUT_DS) + (size_t)item * 8192; float* GL = (float*)(a.ws + WS_GL) + (size_t)item * 64;
    LAS bf16* vT = (LAS bf16*)(lds + GL_VT); LAS bf16* kdT = (LAS bf16*)(lds + GL_KDT); LAS float* gs = (LAS float*)(lds + GL_GS);
    GlaRaw gr; unsigned short kr[8], vr[16];
    gla_gates_load(a, P, b, h, n, wave, lane, gr);
#pragma unroll
    for (int i = 0; i < 8; ++i) kr[i] = P[rowof(b, n * CH + wave * 8 + i) * NIN + C_GK + h * 64 + lane];
    load_v_raw(P, b, n, C_GV + h * 128, tid, vr);
    SB();
    float bc[8], blast, bref;
    gla_gates_compute(gr, n, wave, lane, gs, bc, blast, bref);
    { unsigned pk[4];
#pragma unroll
      for (int i = 0; i < 4; ++i) pk[i] = pk2(bf2f(kr[2 * i]) * __expf(blast - bc[2 * i]), bf2f(kr[2 * i + 1]) * __expf(blast - bc[2 * i + 1]));
      *(LAS v4u*)(kdT + lane * LD72 + wave * 8) = (v4u){pk[0], pk[1], pk[2], pk[3]}; }
    store_vT(vr, vT, tid);
    if (wave == 0) GL[lane] = __expf(blast);
    LBAR();
    const int fr = lane & 15, fq = lane >> 4;
    bf16x8 X[2];
#pragma unroll
    for (int ks = 0; ks < 2; ++ks) X[ks] = *(const LAS bf16x8*)(vT + (16 * wave + fr) * LD72 + 32 * ks + 8 * fq);
#pragma unroll
    for (int nt = 0; nt < 4; ++nt) { f32x4 acc = {0.f, 0.f, 0.f, 0.f};
#pragma unroll
        for (int ks = 0; ks < 2; ++ks) { const bf16x8 Y = *(const LAS bf16x8*)(kdT + (16 * nt + fr) * LD72 + 32 * ks + 8 * fq); acc = MFMA16(Y, X[ks], acc); }
        *(f32x4*)(DS + (16 * wave + fr) * 64 + 16 * nt + 4 * fq) = acc; }
    LBAR();
}
__device__ __forceinline__ void gla_p3_scan(const Args& a, int tid) {
    const int G = gridDim.x;
    for (int gid = blockIdx.x * NTHREADS + tid; gid < 64 * 2048; gid += G * NTHREADS) {
        const int bh = gid >> 11, within = gid & 2047, e = within >> 4, d4 = (within & 15) * 4;
        float* DS = (float*)((unsigned char*)a.out + OUT_DS) + (size_t)bh * 64 * 8192 + e * 64 + d4; const float* GL = (const float*)(a.ws + WS_GL) + (size_t)bh * 64 * 64 + d4;
        f32x4 S = {0.f, 0.f, 0.f, 0.f};
        for (int n0 = 0; n0 < 64; n0 += 8) { f32x4 ds[8], gl[8];
#pragma unroll
            for (int j = 0; j < 8; ++j) { ds[j] = *(const f32x4*)(DS + (size_t)(n0 + j) * 8192); gl[j] = *(const f32x4*)(GL + (n0 + j) * 64); }
            SB();
#pragma unroll
            for (int j = 0; j < 8; ++j) { S = gl[j] * S + ds[j]; *(f32x4*)(DS + (size_t)(n0 + j) * 8192) = S; } }
    }
}
__device__ __forceinline__ void gla_p4_item(const Args& a, int item, LAS unsigned char* lds, int tid, int lane, int wave) {
    const int n = (item & 63) + 1, h = (item >> 6) & 3, b = item >> 8;
    const bf16* P = (const bf16*)(a.ws + WS_P); bf16* MIX = (bf16*)(a.ws + WS_MIX);
    const float* SN = (const float*)((const unsigned char*)a.out + OUT_DS) + (size_t)item * 8192;
    LAS bf16* vT = (LAS bf16*)(lds + GL_VT); LAS bf16* QI = (LAS bf16*)(lds + GL_QI); LAS bf16* KI = (LAS bf16*)(lds + GL_KI); LAS bf16* QG = (LAS bf16*)(lds + GL_QG); LAS bf16* Ab = (LAS bf16*)(lds + GL_AB);
    LAS float* gs = (LAS float*)(lds + GL_GS); LAS float* ss = (LAS float*)(lds + GL_SS);
    const size_t row0 = (size_t)b * SEQ + (size_t)(n - 1) * CH;
    const int fr = lane & 15, fq = lane >> 4;
    GlaRaw gr; unsigned short qr[8], kr[8], vr[16];
    gla_gates_load(a, P, b, h, n, wave, lane, gr);
#pragma unroll
    for (int i = 0; i < 8; ++i) { const bf16* pr = P + (row0 + wave * 8 + i) * NIN; qr[i] = pr[C_GQ + h * 64 + lane]; kr[i] = pr[C_GK + h * 64 + lane]; }
    load_v_raw(P, b, n, C_GV + h * 128, tid, vr);
    const int mt = wave & 3, c = 16 * mt + fr;
    f32x4 sn[4][2][2]; v2u rz[4]; f32x4 gv[4];
#pragma unroll
    for (int i = 0; i < 4; ++i) { const int nt = 4 * (wave >> 2) + i;
#pragma unroll
        for (int ks = 0; ks < 2; ++ks) { const float* sp = SN + (16 * nt + fr) * 64 + 32 * ks + 8 * fq; sn[i][ks][0] = *(const f32x4*)sp; sn[i][ks][1] = *(const f32x4*)(sp + 4); }
        const int e0 = 16 * nt + 4 * fq; rz[i] = *(const v2u*)(P + (row0 + c) * NIN + C_GR + h * 128 + e0); gv[i] = *(const f32x4*)(a.gla_norm_g + e0); }
    SB();
    float bc[8], blast, bref;
    gla_gates_compute(gr, n, wave, lane, gs, bc, blast, bref);
#pragma unroll
    for (int i = 0; i < 8; ++i) { const int cc = wave * 8 + i; const float q = bf2f(qr[i]) * 0.125f, k = bf2f(kr[i]);
        QI[cc * LD72 + lane] = (bf16)f2bf(q * __expf(bc[i] - bref)); KI[cc * LD72 + lane] = (bf16)f2bf(k * __expf(bref - bc[i])); QG[cc * LD72 + lane] = (bf16)f2bf(q * __expf(bc[i])); }
    store_vT(vr, vT, tid);
    LBAR();
    { const int mta = wave >> 1; bf16x8 X[2], Y[2][2];
#pragma unroll
      for (int ks = 0; ks < 2; ++ks) { X[ks] = *(const LAS bf16x8*)(QI + (16 * mta + fr) * LD72 + 32 * ks + 8 * fq);
#pragma unroll
          for (int j2 = 0; j2 < 2; ++j2) Y[j2][ks] = *(const LAS bf16x8*)(KI + (16 * (2 * (wave & 1) + j2) + fr) * LD72 + 32 * ks + 8 * fq); }
#pragma unroll
      for (int j2 = 0; j2 < 2; ++j2) { const int nt = 2 * (wave & 1) + j2; f32x4 acc = {0.f, 0.f, 0.f, 0.f};
#pragma unroll
          for (int ks = 0; ks < 2; ++ks) acc = MFMA16(Y[j2][ks], X[ks], acc);
          const int ca = 16 * mta + fr, s0 = 16 * nt + 4 * fq;
#pragma unroll
          for (int j = 0; j < 4; ++j) if (s0 + j > ca) acc[j] = 0.f;
          *(LAS v2u*)(Ab + ca * LD72 + s0) = (v2u){pk2(acc[0], acc[1]), pk2(acc[2], acc[3])}; } }
    LBAR();
    f32x4 o[4];
    { bf16x8 XA[2], XQ[2], YV[4][2];
#pragma unroll
      for (int ks = 0; ks < 2; ++ks) { XA[ks] = *(const LAS bf16x8*)(Ab + c * LD72 + 32 * ks + 8 * fq); XQ[ks] = *(const LAS bf16x8*)(QG + c * LD72 + 32 * ks + 8 * fq);
#pragma unroll
          for (int i = 0; i < 4; ++i) YV[i][ks] = *(const LAS bf16x8*)(vT + (16 * (4 * (wave >> 2) + i) + fr) * LD72 + 32 * ks + 8 * fq); }
#pragma unroll
      for (int i = 0; i < 4; ++i) { f32x4 acc = {0.f, 0.f, 0.f, 0.f};
#pragma unroll
          for (int ks = 0; ks < 2; ++ks) acc = MFMA16(YV[i][ks], XA[ks], acc);
#pragma unroll
          for (int ks = 0; ks < 2; ++ks) { const f32x4 s0 = sn[i][ks][0], s1 = sn[i][ks][1];
              const v4u yp = {pk2(s0[0], s0[1]), pk2(s0[2], s0[3]), pk2(s1[0], s1[1]), pk2(s1[2], s1[3])}; acc = MFMA16(__builtin_bit_cast(bf16x8, yp), XQ[ks], acc); }
          o[i] = acc; } }
    float sq = 0.f;
#pragma unroll
    for (int i = 0; i < 4; ++i) sq += (o[i][0] * o[i][0] + o[i][1] * o[i][1]) + (o[i][2] * o[i][2] + o[i][3] * o[i][3]);
    sq += __shfl_xor(sq, 16); sq += __shfl_xor(sq, 32);
    if (fq == 0) ss[(wave >> 2) * 64 + c] = sq;
    LBAR();
    const float rstd = rsqrtf((ss[c] + ss[64 + c]) * (1.f / 128.f) + EPS);
#pragma unroll
    for (int i = 0; i < 4; ++i) { const int e0 = 16 * (4 * (wave >> 2) + i) + 4 * fq;
        const float r0 = o[i][0] * rstd * gv[i][0] * siluf_(bflo(rz[i].x)), r1 = o[i][1] * rstd * gv[i][1] * siluf_(bfhi(rz[i].x)), r2 = o[i][2] * rstd * gv[i][2] * siluf_(bflo(rz[i].y)), r3 = o[i][3] * rstd * gv[i][3] * siluf_(bfhi(rz[i].y));
        *(v2u*)(MIX + (row0 + c) * D + 512 + h * 128 + e0) = (v2u){pk2(r0, r1), pk2(r2, r3)}; }
    LBAR();
}

typedef float f32x2 __attribute__((ext_vector_type(2)));
constexpr int LD136 = 136;
constexpr int LDF = 68;
constexpr int DN_KL = 0, DN_VL = 17408, DN_KBGT = 34816, DN_VBT = 53248, DN_AF = 71680, DN_TF = 89088, DN_TB = 106496, DN_XS = 115712, DN_YS = 117760, DN_GC = 122880, DN_BETA = 123136;
constexpr float QSCALE = 0.08838834764831845f;

__device__ __forceinline__ void dn_p2_item(const Args& a, int item, LAS unsigned char* lds, int tid, int lane, int wave) {
    const int n = item % 65, bh = item / 65, h = bh & 3, b = bh >> 2;
    const int itemq = bh * 64 + n - 1;
    const bf16* P = (const bf16*)(a.ws + WS_P);
    bf16* QH = (bf16*)(a.ws + WS_QH) + (size_t)itemq * 8192; bf16* KH = (bf16*)(a.ws + WS_KH) + (size_t)itemq * 8192;
    bf16* KT = (bf16*)(a.ws + WS_KT) + (size_t)item * 8192; bf16* Wg = (bf16*)(a.ws + WS_W) + (size_t)item * 8192; bf16* UT = (bf16*)(a.ws + WS_UT) + (size_t)item * 8192;
    float* GC = (float*)(a.ws + WS_GC) + (size_t)item * 64;
    LAS bf16* Kl = (LAS bf16*)(lds + DN_KL); LAS bf16* Vl = (LAS bf16*)(lds + DN_VL); LAS bf16* KBGt = (LAS bf16*)(lds + DN_KBGT); LAS bf16* VBt = (LAS bf16*)(lds + DN_VBT);
    LAS float* Af = (LAS float*)(lds + DN_AF); LAS float* Tf = (LAS float*)(lds + DN_TF); LAS bf16* Tb = (LAS bf16*)(lds + DN_TB);
    LAS float* Xs = (LAS float*)(lds + DN_XS); LAS float* Ys = (LAS float*)(lds + DN_YS); LAS float* gcl = (LAS float*)(lds + DN_GC); LAS float* betal = (LAS float*)(lds + DN_BETA);
    const int fr = lane & 15, fq = lane >> 4;
    { const int j = tid & 15, rg = tid >> 4;
      v4u raw[3][5]; unsigned short gb = 0, ga = 0;
#pragma unroll
      for (int rr = 0; rr < 5; ++rr) { const int t = n * CH + 2 * rg - 3 + rr; const bf16* pr = P + rowof(b, t < 0 ? 0 : t) * NIN + h * 128 + 8 * j;
#pragma unroll
          for (int arr = 0; arr < 3; ++arr) { raw[arr][rr] = *(const v4u*)(pr + arr * 512); if (t < 0) raw[arr][rr] = (v4u){0u, 0u, 0u, 0u}; } }
      if (wave == 0) { const bf16* pr = P + rowof(b, n * CH + lane) * NIN; gb = pr[C_BETA + h]; ga = pr[C_A + h]; }
      SB();
#pragma unroll
      for (int arr = 0; arr < 3; ++arr) {
          const int col = arr * 512 + h * 128 + 8 * j;
          f32x4 w0[4], w1[4];
#pragma unroll
          for (int i = 0; i < 4; ++i) { w0[i] = *(const f32x4*)(a.conv_w + i * 1536 + col); w1[i] = *(const f32x4*)(a.conv_w + i * 1536 + col + 4); }
          SB();
          float x[5][8];
#pragma unroll
          for (int rr = 0; rr < 5; ++rr) { const v4u r4 = raw[arr][rr];
              x[rr][0] = bflo(r4.x); x[rr][1] = bfhi(r4.x); x[rr][2] = bflo(r4.y); x[rr][3] = bfhi(r4.y); x[rr][4] = bflo(r4.z); x[rr][5] = bfhi(r4.z); x[rr][6] = bflo(r4.w); x[rr][7] = bfhi(r4.w); }
          float y[2][8];
#pragma unroll
          for (int r = 0; r < 2; ++r)
#pragma unroll
              for (int c8 = 0; c8 < 8; ++c8) y[r][c8] = 0.f;
#pragma unroll
          for (int i = 0; i < 4; ++i) {
#pragma unroll
              for (int r = 0; r < 2; ++r) { y[r][0] += w0[i][0] * x[r + i][0]; y[r][1] += w0[i][1] * x[r + i][1]; y[r][2] += w0[i][2] * x[r + i][2]; y[r][3] += w0[i][3] * x[r + i][3];
                  y[r][4] += w1[i][0] * x[r + i][4]; y[r][5] += w1[i][1] * x[r + i][5]; y[r][6] += w1[i][2] * x[r + i][6]; y[r][7] += w1[i][3] * x[r + i][7]; } }
#pragma unroll
          for (int r = 0; r < 2; ++r) { const int c = 2 * rg + r;
#pragma unroll
              for (int c8 = 0; c8 < 8; ++c8) y[r][c8] = siluf_(y[r][c8]);
              if (arr < 2) { float sq = 0.f;
#pragma unroll
                  for (int c8 = 0; c8 < 8; ++c8) sq += y[r][c8] * y[r][c8];
                  sq += __shfl_xor(sq, 1); sq += __shfl_xor(sq, 2); sq += __shfl_xor(sq, 4); sq += __shfl_xor(sq, 8);
                  const float rs = rsqrtf(sq + EPS) * (arr == 0 ? QSCALE : 1.f);
#pragma unroll
                  for (int c8 = 0; c8 < 8; ++c8) y[r][c8] *= rs; }
              const v4u pk = {pk2(y[r][0], y[r][1]), pk2(y[r][2], y[r][3]), pk2(y[r][4], y[r][5]), pk2(y[r][6], y[r][7])};
              if (arr == 0) { if (n >= 1) *(v4u*)(QH + c * 128 + 8 * j) = pk; }
              else if (arr == 1) { *(LAS v4u*)(Kl + c * LD136 + 8 * j) = pk; if (n >= 1) *(v4u*)(KH + c * 128 + 8 * j) = pk; }
              else { *(LAS v4u*)(Vl + c * LD136 + 8 * j) = pk; } } }
      if (wave == 0) { const int t = n * CH + lane;
          const float beta = sigmoidf_(bf2f(gb)); float g = -__expf(a.a_log[h]) * softplusf_(bf2f(ga) + a.dt_bias[h]); if (t < NPAD) g = 0.f;
#pragma unroll
          for (int o = 1; o < 64; o <<= 1) { const float up = __shfl_up(g, o); if (lane >= o) g += up; }
          gcl[lane] = g; betal[lane] = beta; GC[lane] = g; } }
    for (int i = tid; i < 64 * LDF; i += NTHREADS) Tf[i] = 0.f;
    LBAR();
    { const int mt = wave >> 1; bf16x8 X[4], Y[2][4];
#pragma unroll
      for (int ks = 0; ks < 4; ++ks) { X[ks] = *(const LAS bf16x8*)(Kl + (16 * mt + fr) * LD136 + 32 * ks + 8 * fq);
#pragma unroll
          for (int j2 = 0; j2 < 2; ++j2) Y[j2][ks] = *(const LAS bf16x8*)(Kl + (16 * (2 * (wave & 1) + j2) + fr) * LD136 + 32 * ks + 8 * fq); }
      const int c = 16 * mt + fr; const float bc = betal[c], gcc = gcl[c];
#pragma unroll
      for (int j2 = 0; j2 < 2; ++j2) { const int nt = 2 * (wave & 1) + j2; f32x4 acc = {0.f, 0.f, 0.f, 0.f};
#pragma unroll
          for (int ks = 0; ks < 4; ++ks) acc = MFMA16(Y[j2][ks], X[ks], acc);
          const int s0 = 16 * nt + 4 * fq; const f32x4 gsv = *(const LAS f32x4*)(gcl + s0);
#pragma unroll
          for (int jj = 0; jj < 4; ++jj) { const float ev = __expf(fminf(gcc - gsv[jj], 0.f)); acc[jj] = (s0 + jj < c) ? acc[jj] * bc * ev : 0.f; }
          *(LAS f32x4*)(Af + c * LDF + s0) = acc; } }
    { const int d = tid & 127, cg4 = tid >> 7; unsigned short kk[16], vv[16]; float bb[16], ee[16];
#pragma unroll
      for (int i = 0; i < 16; ++i) { const int s = 16 * cg4 + i; kk[i] = Kl[s * LD136 + d]; vv[i] = Vl[s * LD136 + d]; }
#pragma unroll
      for (int i4 = 0; i4 < 4; ++i4) { const f32x4 b4 = *(const LAS f32x4*)(betal + 16 * cg4 + 4 * i4), g4 = *(const LAS f32x4*)(gcl + 16 * cg4 + 4 * i4);
#pragma unroll
          for (int jj = 0; jj < 4; ++jj) { bb[4 * i4 + jj] = b4[jj]; ee[4 * i4 + jj] = __expf(g4[jj]); } }
      unsigned pkk[8], pkb[8], pkv[8];
#pragma unroll
      for (int i = 0; i < 8; ++i) { pkk[i] = (unsigned)kk[2 * i] | ((unsigned)kk[2 * i + 1] << 16);
          pkb[i] = pk2(bf2f(kk[2 * i]) * bb[2 * i] * ee[2 * i], bf2f(kk[2 * i + 1]) * bb[2 * i + 1] * ee[2 * i + 1]); pkv[i] = pk2(bf2f(vv[2 * i]) * bb[2 * i], bf2f(vv[2 * i + 1]) * bb[2 * i + 1]); }
      *(LAS v4u*)(KBGt + d * LD72 + 16 * cg4) = (v4u){pkb[0], pkb[1], pkb[2], pkb[3]}; *(LAS v4u*)(KBGt + d * LD72 + 16 * cg4 + 8) = (v4u){pkb[4], pkb[5], pkb[6], pkb[7]};
      *(LAS v4u*)(VBt + d * LD72 + 16 * cg4) = (v4u){pkv[0], pkv[1], pkv[2], pkv[3]}; *(LAS v4u*)(VBt + d * LD72 + 16 * cg4 + 8) = (v4u){pkv[4], pkv[5], pkv[6], pkv[7]};
      *(v4u*)(KT + d * 64 + 16 * cg4) = (v4u){pkk[0], pkk[1], pkk[2], pkk[3]}; *(v4u*)(KT + d * 64 + 16 * cg4 + 8) = (v4u){pkk[4], pkk[5], pkk[6], pkk[7]}; }
    LBAR();
    if (tid < 64) { const int i = tid >> 4, col = tid & 15; float x[16]; f32x4 ar[16][4];
#pragma unroll
        for (int r = 1; r < 16; ++r)
#pragma unroll
            for (int j4 = 0; j4 < 4; ++j4) if (4 * j4 < r) ar[r][j4] = *(const LAS f32x4*)(Af + (16 * i + r) * LDF + 16 * i + 4 * j4);
#pragma unroll
        for (int r = 0; r < 16; ++r) { float s = (r == col) ? 1.f : 0.f;
#pragma unroll
            for (int j4 = 0; j4 < 4; ++j4) { if (4 * j4 < r) {
#pragma unroll
                for (int jj = 0; jj < 4; ++jj) if (4 * j4 + jj < r) s -= ar[r][j4][jj] * x[4 * j4 + jj]; } }
            x[r] = s; Tf[(16 * i + r) * LDF + 16 * i + col] = s; } }
    LBAR();
    { const int p = tid >> 8, r = (tid >> 4) & 15, cc = tid & 15, lo = 32 * p; f32x4 av[4]; float tv[16];
#pragma unroll
      for (int j4 = 0; j4 < 4; ++j4) av[j4] = *(const LAS f32x4*)(Af + (lo + 16 + r) * LDF + lo + 4 * j4);
#pragma unroll
      for (int j = 0; j < 16; ++j) tv[j] = Tf[(lo + j) * LDF + lo + cc];
      float s = 0.f;
#pragma unroll
      for (int j = 0; j < 16; ++j) s += av[j >> 2][j & 3] * tv[j];
      Xs[p * 256 + r * 16 + cc] = s;
      LBAR();
#pragma unroll
      for (int j4 = 0; j4 < 4; ++j4) av[j4] = *(const LAS f32x4*)(Tf + (lo + 16 + r) * LDF + lo + 16 + 4 * j4);
#pragma unroll
      for (int j = 0; j < 16; ++j) tv[j] = Xs[p * 256 + j * 16 + cc];
      float s2 = 0.f;
#pragma unroll
      for (int j = 0; j < 16; ++j) s2 += av[j >> 2][j & 3] * tv[j];
      Tf[(lo + 16 + r) * LDF + lo + cc] = -s2; }
    LBAR();
    { const int r = tid >> 4, c2 = (tid & 15) * 2; f32x4 av[8]; f32x2 tv[32];
#pragma unroll
      for (int j4 = 0; j4 < 8; ++j4) av[j4] = *(const LAS f32x4*)(Af + (32 + r) * LDF + 4 * j4);
#pragma unroll
      for (int j = 0; j < 32; ++j) tv[j] = *(const LAS f32x2*)(Tf + j * LDF + c2);
      float s0 = 0.f, s1 = 0.f;
#pragma unroll
      for (int j = 0; j < 32; ++j) { s0 += av[j >> 2][j & 3] * tv[j][0]; s1 += av[j >> 2][j & 3] * tv[j][1]; }
      Ys[r * 33 + c2] = s0; Ys[r * 33 + c2 + 1] = s1;
      LBAR();
#pragma unroll
      for (int j4 = 0; j4 < 8; ++j4) av[j4] = *(const LAS f32x4*)(Tf + (32 + r) * LDF + 32 + 4 * j4);
      float y0[32], y1[32];
#pragma unroll
      for (int j = 0; j < 32; ++j) { y0[j] = Ys[j * 33 + c2]; y1[j] = Ys[j * 33 + c2 + 1]; }
      float t0 = 0.f, t1 = 0.f;
#pragma unroll
      for (int j = 0; j < 32; ++j) { t0 += av[j >> 2][j & 3] * y0[j]; t1 += av[j >> 2][j & 3] * y1[j]; }
      Tf[(32 + r) * LDF + c2] = -t0; Tf[(32 + r) * LDF + c2 + 1] = -t1; }
    LBAR();
    { const int c = tid >> 3, s8 = (tid & 7) * 8; const f32x4 t0 = *(const LAS f32x4*)(Tf + c * LDF + s8), t1 = *(const LAS f32x4*)(Tf + c * LDF + s8 + 4);
      *(LAS v4u*)(Tb + c * LD72 + s8) = (v4u){pk2(t0[0], t0[1]), pk2(t0[2], t0[3]), pk2(t1[0], t1[1]), pk2(t1[2], t1[3])}; }
    LBAR();
    { const int mt = wave & 3; bf16x8 X[2], Y[4][2], XV[2], YT[4][2];
#pragma unroll
      for (int ks = 0; ks < 2; ++ks) { X[ks] = *(const LAS bf16x8*)(Tb + (16 * mt + fr) * LD72 + 32 * ks + 8 * fq); XV[ks] = *(const LAS bf16x8*)(VBt + (16 * wave + fr) * LD72 + 32 * ks + 8 * fq);
#pragma unroll
          for (int i = 0; i < 4; ++i) { Y[i][ks] = *(const LAS bf16x8*)(KBGt + (16 * (4 * (wave >> 2) + i) + fr) * LD72 + 32 * ks + 8 * fq); YT[i][ks] = *(const LAS bf16x8*)(Tb + (16 * i + fr) * LD72 + 32 * ks + 8 * fq); } }
#pragma unroll
      for (int i = 0; i < 4; ++i) { const int nt = 4 * (wave >> 2) + i; f32x4 acc = {0.f, 0.f, 0.f, 0.f};
#pragma unroll
          for (int ks = 0; ks < 2; ++ks) acc = MFMA16(Y[i][ks], X[ks], acc);
          *(v2u*)(Wg + (16 * mt + fr) * 128 + 16 * nt + 4 * fq) = (v2u){pk2(acc[0], acc[1]), pk2(acc[2], acc[3])}; }
#pragma unroll
      for (int nt = 0; nt < 4; ++nt) { f32x4 acc = {0.f, 0.f, 0.f, 0.f};
#pragma unroll
          for (int ks = 0; ks < 2; ++ks) acc = MFMA16(YT[nt][ks], XV[ks], acc);
          *(v2u*)(UT + (16 * wave + fr) * 64 + 16 * nt + 4 * fq) = (v2u){pk2(acc[0], acc[1]), pk2(acc[2], acc[3])}; } }
    LBAR();
}

struct P3Regs { bf16x8 wf[4], ktf[2]; v2u ut; f32x4 gcv; float gclast; f32x4 gds, ggl; };
struct P3Ptrs { const bf16* Wb; bf16* UTb; const bf16* KTb; const float* GCb; const float* GCl; bf16* dummy; bf16* SNb; float* DSg; const float* GLg; int ct, fq; bool gla; };
template <bool GLA> __device__ __forceinline__ void p3_load(P3Regs& r, const P3Ptrs& p, int n) {
    const int nn = n < 65 ? n : 64, ng = n < 64 ? n : 63; const size_t o = (size_t)nn * 8192;
#pragma unroll
    for (int ks = 0; ks < 4; ++ks) r.wf[ks] = *(const bf16x8*)(p.Wb + o + 32 * ks);
#pragma unroll
    for (int ks = 0; ks < 2; ++ks) r.ktf[ks] = *(const bf16x8*)(p.KTb + o + 32 * ks);
    r.ut = *(const v2u*)(p.UTb + o); r.gcv = *(const f32x4*)(p.GCb + nn * 64 + 16 * p.ct + 4 * p.fq); r.gclast = p.GCl[nn * 64];
    if (GLA) { r.gds = *(const f32x4*)(p.DSg + (size_t)ng * 8192); r.ggl = *(const f32x4*)(p.GLg + ng * 64); }
}
template <bool GLA, bool DRY> __device__ __forceinline__ void p3_step(const P3Regs& r, const P3Ptrs& p, int n, f32x4 (&acc)[2], f32x4& Sg, LAS bf16* Sb, LAS bf16* Vt, int fr, int fq, int wave) {
    const int et1 = wave & 1, ct = wave >> 1;
    if (GLA) { Sg = r.ggl * Sg + r.gds; if (!DRY) *(f32x4*)(p.DSg + (size_t)n * 8192) = Sg; }
#pragma unroll
    for (int et = 0; et < 2; ++et) { const v2u sp = {pk2(acc[et][0], acc[et][1]), pk2(acc[et][2], acc[et][3])};
        *(LAS v2u*)(Sb + (16 * et + fr) * LD136 + 16 * wave + 4 * fq) = sp;
        v2u* dst = (n >= 1) ? (v2u*)(p.SNb + (size_t)(n - 1) * 16384 + et * 16 * 128) : (v2u*)(p.dummy + 4 * et); *dst = sp; }
    LBAR();
    { f32x4 av = {0.f, 0.f, 0.f, 0.f};
      const LAS bf16* xp = Sb + (16 * et1 + fr) * LD136 + 8 * fq;
      const bf16x8 x0 = *(const LAS bf16x8*)(xp), x1 = *(const LAS bf16x8*)(xp + 32), x2 = *(const LAS bf16x8*)(xp + 64), x3 = *(const LAS bf16x8*)(xp + 96);
      av = MFMA16(r.wf[0], x0, av); av = MFMA16(r.wf[1], x1, av); av = MFMA16(r.wf[2], x2, av); av = MFMA16(r.wf[3], x3, av);
      const float v0 = bflo(r.ut.x) - av[0], v1 = bfhi(r.ut.x) - av[1], v2 = bflo(r.ut.y) - av[2], v3 = bfhi(r.ut.y) - av[3];
      if (!DRY) *(v2u*)(p.UTb + (size_t)n * 8192) = (v2u){pk2(v0, v1), pk2(v2, v3)};
      *(LAS v2u*)(Vt + (16 * et1 + fr) * LD72 + 16 * ct + 4 * fq) = (v2u){pk2(v0 * __expf(r.gclast - r.gcv[0]), v1 * __expf(r.gclast - r.gcv[1])), pk2(v2 * __expf(r.gclast - r.gcv[2]), v3 * __expf(r.gclast - r.gcv[3]))}; }
    LBAR();
    { const float gl = __expf(r.gclast);
      const LAS bf16* xp0 = Vt + fr * LD72 + 8 * fq; const LAS bf16* xp1 = Vt + (16 + fr) * LD72 + 8 * fq;
      const bf16x8 a0 = *(const LAS bf16x8*)(xp0), a1 = *(const LAS bf16x8*)(xp0 + 32), b0 = *(const LAS bf16x8*)(xp1), b1 = *(const LAS bf16x8*)(xp1 + 32);
      acc[0] = acc[0] * gl; acc[1] = acc[1] * gl;
      acc[0] = MFMA16(r.ktf[0], a0, acc[0]); acc[1] = MFMA16(r.ktf[0], b0, acc[1]); acc[0] = MFMA16(r.ktf[1], a1, acc[0]); acc[1] = MFMA16(r.ktf[1], b1, acc[1]); }
}
template <bool GLA, bool DRY> __device__ __forceinline__ void dn_p3_unit(const Args& a, int unit, LAS unsigned char* lds, int tid, int lane, int wave) {
    const int sl = unit & 3, bh = unit >> 2;
    LAS bf16* Sb = (LAS bf16*)lds; LAS bf16* Vt = (LAS bf16*)(lds + 8704);
    const int fr = lane & 15, fq = lane >> 4, et1 = wave & 1, ct = wave >> 1;
    f32x4 acc[2] = {{0.f, 0.f, 0.f, 0.f}, {0.f, 0.f, 0.f, 0.f}}; f32x4 Sg = {0.f, 0.f, 0.f, 0.f};
    P3Ptrs p;
    p.Wb = (const bf16*)(a.ws + WS_W) + (size_t)bh * 65 * 8192 + (16 * ct + fr) * 128 + 8 * fq;
    p.UTb = (bf16*)(a.ws + WS_UT) + (size_t)bh * 65 * 8192 + (32 * sl + 16 * et1 + fr) * 64 + 16 * ct + 4 * fq;
    p.KTb = (const bf16*)(a.ws + WS_KT) + (size_t)bh * 65 * 8192 + (16 * wave + fr) * 64 + 8 * fq;
    p.GCb = (const float*)(a.ws + WS_GC) + (size_t)bh * 65 * 64;
    { int z = lane; asm volatile("" : "+v"(z)); p.GCl = p.GCb + 63 + (z & 64); }
    p.SNb = (bf16*)a.out + (size_t)bh * 64 * 16384 + (32 * sl + fr) * 128 + 16 * wave + 4 * fq;
    { const int gid = blockIdx.x * NTHREADS + tid, gbh = gid >> 11, within = gid & 2047, e = within >> 4, d4 = (within & 15) * 4;
      p.DSg = (float*)((unsigned char*)a.out + OUT_DS) + (size_t)gbh * 64 * 8192 + e * 64 + d4; p.GLg = (const float*)(a.ws + WS_GL) + (size_t)gbh * 64 * 64 + d4; }
    p.ct = ct; p.fq = fq; p.gla = GLA; p.dummy = (bf16*)(a.ws + 972 * MiB) + (size_t)(blockIdx.x * NTHREADS + tid) * 8;
    P3Regs R0, R1, R2;
    for (int n = 0; n < 63; n += 3) {
        p3_load<GLA>(R0, p, n); p3_load<GLA>(R1, p, n + 1); p3_load<GLA>(R2, p, n + 2);
        SB();
        p3_step<GLA, DRY>(R0, p, n, acc, Sg, Sb, Vt, fr, fq, wave);
        p3_step<GLA, DRY>(R1, p, n + 1, acc, Sg, Sb, Vt, fr, fq, wave);
        p3_step<GLA, DRY>(R2, p, n + 2, acc, Sg, Sb, Vt, fr, fq, wave);
        SB();
    }
    p3_load<GLA>(R0, p, 63); p3_load<false>(R1, p, 64);
    SB();
    p3_step<GLA, DRY>(R0, p, 63, acc, Sg, Sb, Vt, fr, fq, wave);
    p3_step<false, DRY>(R1, p, 64, acc, Sg, Sb, Vt, fr, fq, wave);
    LBAR();
}

__device__ __forceinline__ void dn_p4_wave(const Args& a, int itemq, LAS unsigned char* wl, int lane) {
    const int n = (itemq & 63) + 1, bh = itemq >> 6, h = bh & 3, b = bh >> 2; const int item = bh * 65 + n;
    const bf16* P = (const bf16*)(a.ws + WS_P); bf16* MIX = (bf16*)(a.ws + WS_MIX);
    const bf16* QH = (const bf16*)(a.ws + WS_QH) + (size_t)itemq * 8192; const bf16* KH = (const bf16*)(a.ws + WS_KH) + (size_t)itemq * 8192;
    const bf16* VN = (const bf16*)(a.ws + WS_UT) + (size_t)item * 8192; const bf16* SN = (const bf16*)a.out + (size_t)itemq * 16384;
    const float* GC = (const float*)(a.ws + WS_GC) + (size_t)item * 64;
    LAS bf16* Ab = (LAS bf16*)wl; LAS float* gcl = (LAS float*)(wl + 9216);
    const size_t row0 = (size_t)b * SEQ + (size_t)(n - 1) * CH;
    const int fr = lane & 15, fq = lane >> 4;
    gcl[lane] = GC[lane];
    LDS_WAIT();
#pragma unroll
    for (int mt = 0; mt < 4; ++mt) { const int c = 16 * mt + fr; bf16x8 X[4], Y[4][4];
#pragma unroll
        for (int ks = 0; ks < 4; ++ks) { X[ks] = *(const bf16x8*)(QH + c * 128 + 32 * ks + 8 * fq);
#pragma unroll
            for (int nt = 0; nt < 4; ++nt) if (nt <= mt) Y[nt][ks] = *(const bf16x8*)(KH + (16 * nt + fr) * 128 + 32 * ks + 8 * fq); }
        SB();
        const float gcc = gcl[c];
#pragma unroll
        for (int nt = 0; nt < 4; ++nt) { f32x4 acc = {0.f, 0.f, 0.f, 0.f}; const int s0 = 16 * nt + 4 * fq; const f32x4 gsv = *(const LAS f32x4*)(gcl + s0);
            if (nt <= mt) {
#pragma unroll
                for (int ks = 0; ks < 4; ++ks) acc = MFMA16(Y[nt][ks], X[ks], acc);
#pragma unroll
                for (int jj = 0; jj < 4; ++jj) { const float ev = __expf(fminf(gcc - gsv[jj], 0.f)); acc[jj] = (s0 + jj <= c) ? acc[jj] * ev : 0.f; } }
            *(LAS v2u*)(Ab + c * LD72 + s0) = (v2u){pk2(acc[0], acc[1]), pk2(acc[2], acc[3])}; }
        SB(); }
    LDS_WAIT();
#pragma unroll 1
    for (int mt = 0; mt < 4; ++mt) { const int c = 16 * mt + fr; bf16x8 XQ[4], XA[2]; f32x4 o[8];
        const float eg = __expf(gcl[c]);
        v2u rz[8];
#pragma unroll
        for (int nt = 0; nt < 8; ++nt) rz[nt] = *(const v2u*)(P + (row0 + c) * NIN + C_DZ + h * 128 + 16 * nt + 4 * fq);
#pragma unroll
        for (int ks = 0; ks < 4; ++ks) XQ[ks] = *(const bf16x8*)(QH + c * 128 + 32 * ks + 8 * fq);
#pragma unroll
        for (int ks = 0; ks < 2; ++ks) XA[ks] = *(const LAS bf16x8*)(Ab + c * LD72 + 32 * ks + 8 * fq);
#pragma unroll
        for (int qd = 0; qd < 4; ++qd) { bf16x8 YS[2][4], YV[2][2];
#pragma unroll
            for (int i = 0; i < 2; ++i) { const int nt = 2 * qd + i;
#pragma unroll
                for (int ks = 0; ks < 4; ++ks) YS[i][ks] = *(const bf16x8*)(SN + (16 * nt + fr) * 128 + 32 * ks + 8 * fq);
#pragma unroll
                for (int ks = 0; ks < 2; ++ks) YV[i][ks] = *(const bf16x8*)(VN + (16 * nt + fr) * 64 + 32 * ks + 8 * fq); }
            SB();
#pragma unroll
            for (int i = 0; i < 2; ++i) { f32x4 acc = {0.f, 0.f, 0.f, 0.f};
#pragma unroll
                for (int ks = 0; ks < 4; ++ks) acc = MFMA16(YS[i][ks], XQ[ks], acc);
                acc = acc * eg;
#pragma unroll
                for (int ks = 0; ks < 2; ++ks) acc = MFMA16(YV[i][ks], XA[ks], acc);
                o[2 * qd + i] = acc; }
            SB(); }
        float sq = 0.f;
#pragma unroll
        for (int nt = 0; nt < 8; ++nt) sq += (o[nt][0] * o[nt][0] + o[nt][1] * o[nt][1]) + (o[nt][2] * o[nt][2] + o[nt][3] * o[nt][3]);
        sq += __shfl_xor(sq, 16); sq += __shfl_xor(sq, 32);
        const float rstd = rsqrtf(sq * (1.f / 128.f) + EPS);
        { f32x4 gv[8];
#pragma unroll
          for (int nt = 0; nt < 8; ++nt) gv[nt] = *(const f32x4*)(a.dn_norm_g + 16 * nt + 4 * fq);
          SB();
#pragma unroll
          for (int nt = 0; nt < 8; ++nt) { const int e0 = 16 * nt + 4 * fq;
              const float r0 = o[nt][0] * rstd * gv[nt][0] * siluf_(bflo(rz[nt].x)), r1 = o[nt][1] * rstd * gv[nt][1] * siluf_(bfhi(rz[nt].x)), r2 = o[nt][2] * rstd * gv[nt][2] * siluf_(bflo(rz[nt].y)), r3 = o[nt][3] * rstd * gv[nt][3] * siluf_(bfhi(rz[nt].y));
              *(v2u*)(MIX + (row0 + c) * D + h * 128 + e0) = (v2u){pk2(r0, r1), pk2(r2, r3)}; }
          SB(); } }
    LDS_WAIT();
}

constexpr size_t WS_BAR = 974 * MiB;
#define XB_TMO      128
#define XB_XCNT(j)  (256  + 64 * (j))
#define XB_XSUB(j)  (1280 + 64 * (j))
#define XB_XGEN(j)  (2304 + 64 * (j))
#define XB_TOP      3328
#define XB_TOPGEN   3392
#define XCD_BAR_WORDS 3456
#define XB_SPIN_CAP (1u << 18)

__device__ __forceinline__ unsigned xb_ld(unsigned* p)              { return __hip_atomic_load(p, __ATOMIC_RELAXED, __HIP_MEMORY_SCOPE_AGENT); }
__device__ __forceinline__ unsigned xb_add(unsigned* p, unsigned v) { return __hip_atomic_fetch_add(p, v, __ATOMIC_RELAXED, __HIP_MEMORY_SCOPE_AGENT); }
__device__ __forceinline__ unsigned xb_xcc_id() { return (unsigned)__builtin_amdgcn_s_getreg((3 << 11) | 20) & 0xFu; }
#define XB_SPIN(cond, bar) do { unsigned _sp = 0; while (cond) { __builtin_amdgcn_s_sleep(1); \
    if ((++_sp & 255u) == 0u) { if (xb_ld(&(bar)[XB_TMO])) break; if (_sp > XB_SPIN_CAP) { atomicAdd(&(bar)[XB_TMO], 1u); break; } } } } while (0)

struct XcdBarrier {
    unsigned* bar; unsigned x;
    volatile LAS unsigned* st;
};

__device__ __forceinline__ XcdBarrier xcd_barrier_post(unsigned* bar, volatile LAS unsigned* st) {
    XcdBarrier b; b.bar = bar; b.x = xb_xcc_id(); b.st = st;
    if (threadIdx.x == 0) (void)xb_add(&bar[XB_XCNT(b.x)], 1u);
    return b;
}
__device__ __forceinline__ void xcd_barrier_complete(unsigned* bar, unsigned x, unsigned& nloc, unsigned& nx) {
    const unsigned G = gridDim.x * gridDim.y * gridDim.z;
    unsigned sum, cnt, mine, sp = 0u;
    for (;;) {
        sum = 0u; cnt = 0u; mine = 0u;
#pragma unroll
        for (unsigned j = 0; j < 16; ++j) { const unsigned c = xb_ld(&bar[XB_XCNT(j)]); sum += c; cnt += (c > 0u) ? 1u : 0u; mine = (j == x) ? c : mine; }
        if (sum == G) break;
        __builtin_amdgcn_s_sleep(1);
        if ((++sp & 255u) == 0u) { if (xb_ld(&bar[XB_TMO])) break; if (sp > XB_SPIN_CAP) { atomicAdd(&bar[XB_TMO], 1u); break; } }
    }
    nloc = mine > 0u ? mine : 1u; nx = cnt > 0u ? cnt : 1u;
}

__device__ __forceinline__ void xcd_barrier(const XcdBarrier& b) {
    asm volatile("s_waitcnt vmcnt(0)" ::: "memory");
    __syncthreads();
    if (threadIdx.x == 0) {
        unsigned* bar = b.bar;
        __builtin_amdgcn_s_waitcnt(0);
        unsigned nloc = b.st[0], nx = b.st[1];
        if (nloc == 0u) { xcd_barrier_complete(bar, b.x, nloc, nx); b.st[0] = nloc; b.st[1] = nx; }
        const unsigned old = xb_add(&bar[XB_XSUB(b.x)], 1u);
        const unsigned gen = old / nloc;
        if (old + 1u == (gen + 1u) * nloc) {
            __builtin_amdgcn_fence(__ATOMIC_RELEASE, "agent");
            asm volatile("s_waitcnt vmcnt(0)" ::: "memory");
            const unsigned og = xb_add(&bar[XB_TOP], 1u);
            const unsigned tg = og / nx;
            if (og + 1u == (tg + 1u) * nx) xb_add(&bar[XB_TOPGEN], 1u);
            else XB_SPIN(xb_ld(&bar[XB_TOPGEN]) == tg, bar);
            __builtin_amdgcn_fence(__ATOMIC_ACQUIRE, "agent");
            xb_add(&bar[XB_XGEN(b.x)], 1u);
            asm volatile("s_waitcnt vmcnt(0)" ::: "memory");
        } else {
            XB_SPIN(xb_ld(&bar[XB_XGEN(b.x)]) == gen, bar);
            __builtin_amdgcn_fence(__ATOMIC_ACQUIRE, "agent");
            asm volatile("s_waitcnt vmcnt(0)" ::: "memory");
        }
    }
    __syncthreads();
}

__device__ __forceinline__ int fresh_tid() { int t = threadIdx.x; asm volatile("" : "+v"(t)); return t; }
#define GASP __attribute__((address_space(1)))
#define PHASE_IDS const int tid = fresh_tid(), lane = tid & 63, wave = __builtin_amdgcn_readfirstlane(tid >> 6); const int gw = blockIdx.x * NWAVES + wave; (void)gw; (void)lane; (void)tid; \
    Args al = a; { GASP unsigned char* w_ = (GASP unsigned char*)a.ws; GASP float* o_ = (GASP float*)a.out; asm volatile("" : "+s"(w_), "+s"(o_)); al.ws = (unsigned char*)w_; al.out = (float*)o_; }
__global__ void __launch_bounds__(NTHREADS) hymba_fwd(Args a) {
    extern __shared__ __attribute__((aligned(16))) unsigned char lds_raw[];
    cg::grid_group grid = cg::this_grid();
    LAS unsigned char* lds = (LAS unsigned char*)lds_raw;
    const int G = gridDim.x, NGW = G * NWAVES;
    { volatile LAS unsigned* st = (volatile LAS unsigned*)(lds + 140288); if (threadIdx.x < 2) st[threadIdx.x] = 0u; }
    __syncthreads();
    const XcdBarrier xbar = xcd_barrier_post((unsigned*)(a.ws + WS_BAR), (volatile LAS unsigned*)(lds + 140288));

    { PHASE_IDS; p0_prologue(al, lds, tid, lane, wave); }
    grid.sync();
    { PHASE_IDS; pg8::Gemm g{(bf16*)(al.ws + WS_HN), (bf16*)(al.ws + WS_WIN), MR, NIN, D}; pg8::StaticOrder S; S.init(MR, NIN, G, (int)blockIdx.x);
      pg8::EpiBf16<0> E{(bf16*)(al.ws + WS_P), NIN, nullptr, 0, 0, 1.f};
      pg8::gemm_phase<pg8::EpiBf16<0>, pg8::StaticOrder, true, true>(lds, g, S, E); }
    xcd_barrier(xbar);
    { PHASE_IDS;
      for (int it = blockIdx.x; it < 4160 + 4096; it += G) {
          if (it < 4160) { const int bh = it / 65, n = it - bh * 65, b = bh >> 2, b2 = b < 8 ? 2 * b + 1 : 2 * (b - 8); dn_p2_item(al, ((b2 << 2) | (bh & 3)) * 65 + n, lds, tid, lane, wave); }
          else { const int ig = it - 4160, b = ig >> 8, b2 = b < 8 ? 2 * b + 1 : 2 * (b - 8); gla_p2_item(al, (b2 << 8) | (ig & 255), lds, tid, lane, wave); } } }
    xcd_barrier(xbar);
    { PHASE_IDS; const bool fuse = (G == 256);
      if (fuse) {
        for (int u = blockIdx.x; u < 256; u += G) dn_p3_unit<true, false>(al, u, lds, tid, lane, wave); }
      else { for (int u = blockIdx.x; u < 256; u += G) dn_p3_unit<false, false>(al, u, lds, tid, lane, wave); }
      if (!fuse) gla_p3_scan(al, tid); }
    xcd_barrier(xbar);
    { PHASE_IDS;
      for (int it = gw; it < 4096; it += NGW) dn_p4_wave(al, it, lds + wave * 9728, lane); }
    __syncthreads();
    { PHASE_IDS;
      for (int it = blockIdx.x; it < 4096; it += G) gla_p4_item(al, it, lds, tid, lane, wave); }
    xcd_barrier(xbar);
    { PHASE_IDS; pg8::Gemm g{(bf16*)(al.ws + WS_MIX), (bf16*)(al.ws + WS_WOUT), MR, D, D}; pg8::StaticOrder S; S.init(MR, D, G, (int)blockIdx.x);
      pg8::EpiResStats<false> E{al.x, (bf16*)(al.ws + WS_HN), (float*)(al.ws + WS_PS1), D};
      pg8::gemm_phase<pg8::EpiResStats<false>, pg8::StaticOrder, true, true>(lds, g, S, E); }
    xcd_barrier(xbar);
    { PHASE_IDS; pg8::Gemm g{(bf16*)(al.ws + WS_HN), (bf16*)(al.ws + WS_WUP), MR, FF, D}; pg8::StaticOrder S; S.init(MR, FF, G, (int)blockIdx.x);
      pg8::EpiRelu2Scaled E{(bf16*)(al.ws + WS_P), FF, (const float*)(al.ws + WS_PS1)};
      pg8::gemm_phase<pg8::EpiRelu2Scaled, pg8::StaticOrder, true, true>(lds, g, S, E); }
    xcd_barrier(xbar);
    { PHASE_IDS; pg8::Gemm g{(bf16*)(al.ws + WS_P), (bf16*)(al.ws + WS_WDN), MR, D, FF}; pg8::StaticOrder S; S.init(MR, D, G, (int)blockIdx.x);
      pg8::EpiResStats<true> E{(const bf16*)(al.ws + WS_HN), (bf16*)(al.ws + WS_MIX), (float*)(al.ws + WS_PS2), D};
      pg8::gemm_phase<pg8::EpiResStats<true>, pg8::StaticOrder, true, true>(lds, g, S, E); }
    xcd_barrier(xbar);
    { PHASE_IDS; const bf16* YB = (const bf16*)(al.ws + WS_MIX); const float* PS2 = (const float*)(al.ws + WS_PS2);
      const f32x4* gp = (const f32x4*)al.final_g; const f32x4 g0 = gp[2 * lane], g1 = gp[2 * lane + 1], g2 = gp[128 + 2 * lane], g3 = gp[128 + 2 * lane + 1];
      for (int m = gw; m < MR; m += NGW) final_row(YB + (size_t)m * D, PS2 + (size_t)m * 16, g0, g1, g2, g3, al.out + (size_t)m * D, lane); }
}

extern "C" void kernel_launch(void* const* d_in, const int* in_sizes, int n_in, void* d_out, int out_size, void* d_ws, size_t ws_size, hipStream_t stream) {
    static int grid = 0;
    if (grid == 0) {
        int dev = 0, cus = 0, per_cu = 0;
        hipGetDevice(&dev); hipDeviceGetAttribute(&cus, hipDeviceAttributeMultiprocessorCount, dev);
        hipFuncSetAttribute((const void*)hymba_fwd, hipFuncAttributeMaxDynamicSharedMemorySize, LDS_BYTES);
        hipOccupancyMaxActiveBlocksPerMultiprocessor(&per_cu, (const void*)hymba_fwd, NTHREADS, LDS_BYTES);
        if (per_cu < 1) per_cu = 1;
        grid = cus * (per_cu > 1 ? 1 : per_cu);
        (void)hipGetLastError();
    }
    Args a{};
    a.x = (const float*)d_in[0]; a.meta = (const float*)d_in[1]; a.norm1_g = (const float*)d_in[2]; a.w_in = (const float*)d_in[3]; a.conv_w = (const float*)d_in[4];
    a.a_log = (const float*)d_in[5]; a.dt_bias = (const float*)d_in[6]; a.dn_norm_g = (const float*)d_in[7]; a.gla_w2 = (const float*)d_in[8]; a.gla_b = (const float*)d_in[9];
    a.gla_norm_g = (const float*)d_in[10]; a.w_out = (const float*)d_in[11]; a.norm2_g = (const float*)d_in[12]; a.w_up = (const float*)d_in[13]; a.w_down = (const float*)d_in[14];
    a.final_g = (const float*)d_in[15]; a.out = (float*)d_out; a.ws = (unsigned char*)d_ws;
    (void)hipMemsetAsync((char*)d_ws + WS_BAR, 0, XCD_BAR_WORDS * 4, stream);
    void* args[] = {&a};
    hipError_t e = hipLaunchCooperativeKernel((const void*)hymba_fwd, dim3(grid), dim3(NTHREADS), args, LDS_BYTES, stream);
    if (e != hipSuccess) fprintf(stderr, "cooperative launch failed: %s (grid %d)\n", hipGetErrorString(e), grid);
}
```
